# Optimizing an MI355X kernel written in HIP

```python
import math
import jax, jax.numpy as jnp
from jax import lax
import numpy as np

D_MODEL = 1024
BATCH = 2
SEQ = 8192
DEPTH = 2

GRID_W = 64
CTX_LEN = 256
HEAD_DIM = 64
BLOCK = 128
EPS = 1e-6
ROPE_THETA = 10000.0
NEG_INF = -1e30

A_HEADS = 4
A_KV_HEADS = 2
WINDOW = 128
B_HEADS = 4
B_Q_RANK = 192
B_KV_RANK = 128
B_NOPE = 64
B_ROPE = 32
B_V = 64
C_HEADS = 4
C_QK = 32
C_V = 64
D_HEADS = 4
D_KV_HEADS = 2
N_EXPERTS = 16
CAPACITY_FACTOR = 2
D_EXPERT = 1024

A_COLS = A_HEADS * HEAD_DIM + 2 * A_KV_HEADS * HEAD_DIM
B_COLS = B_Q_RANK + B_KV_RANK + B_ROPE
C_COLS = 4 * C_HEADS * C_QK + C_HEADS * C_V
D_COLS = D_HEADS * HEAD_DIM + 2 * D_KV_HEADS * HEAD_DIM
IN_COLS = A_COLS + B_COLS + C_COLS + D_COLS
COL_SPLITS = (A_COLS, A_COLS + B_COLS, A_COLS + B_COLS + C_COLS)
MIX_WIDTH = A_HEADS * HEAD_DIM + B_HEADS * B_V + C_HEADS * C_V + D_HEADS * HEAD_DIM

kernel_name = "hybrid_parallel_heads_diffusion_block"


def rmsnorm(x, g):
    xf = x.astype(jnp.float32)
    y = xf * lax.rsqrt(jnp.mean(xf * xf, axis=-1, keepdims=True) + EPS)
    return (y * g.astype(jnp.float32)).astype(x.dtype)


def modulate(x, g, shift, scale):
    return rmsnorm(x, g) * (1 + scale) + shift


def adaln_params(cond, w_mod, b_mod):
    m = jax.nn.silu(cond) @ w_mod + b_mod
    return [t[..., None, :] for t in jnp.split(m, 6, axis=-1)]


def axial_rope_table(n_tokens, rot_dim):
    rows = n_tokens // GRID_W
    row = jnp.repeat(jnp.arange(rows), GRID_W)
    col = jnp.tile(jnp.arange(GRID_W), rows)
    quarter = rot_dim // 4
    inv_freq = ROPE_THETA ** (-jnp.arange(quarter, dtype=jnp.float32) / quarter)
    ang = jnp.concatenate([row[:, None] * inv_freq, col[:, None] * inv_freq], axis=-1)
    return jnp.cos(ang), jnp.sin(ang)


def apply_rope(x, table):
    cos, sin = table
    cos = cos[None, :, None, :].astype(x.dtype)
    sin = sin[None, :, None, :].astype(x.dtype)
    half = x.shape[-1] // 2
    x1, x2 = x[..., :half], x[..., half:]
    return jnp.concatenate([x1 * cos - x2 * sin, x1 * sin + x2 * cos], axis=-1)


def split_heads(t, n):
    return t.reshape(t.shape[0], t.shape[1], n, -1)


def merge_heads(t):
    return t.reshape(t.shape[0], t.shape[1], -1)


def dense_attention(q, k, v, scale, sink=None):
    b, sq, hq, dk = q.shape
    hkv = k.shape[2]
    g = hq // hkv
    nb = sq // BLOCK
    qb = q.reshape(b, nb, BLOCK, hkv, g, dk).transpose(1, 0, 2, 3, 4, 5)

    def one_block(qblk):
        s = jnp.einsum('bqhgd,bkhd->bhgqk', qblk, k).astype(jnp.float32) * scale
        if sink is not None:
            s_sink = jnp.broadcast_to(sink.astype(jnp.float32).reshape(1, hkv, g, 1, 1), s.shape[:-1] + (1,))
            p = jax.nn.softmax(jnp.concatenate([s, s_sink], axis=-1), axis=-1)[..., :-1]
        else:
            p = jax.nn.softmax(s, axis=-1)
        return jnp.einsum('bhgqk,bkhd->bqhgd', p.astype(v.dtype), v)

    o = lax.map(one_block, qb)
    return o.transpose(1, 0, 2, 3, 4, 5).reshape(b, sq, hq, v.shape[-1])


def window_attention_sink(q, k, v, k_ctx, v_ctx, sink, scale):
    b, s_len, hq, d = q.shape
    hkv = k.shape[2]
    g = hq // hkv
    nb = s_len // BLOCK
    pad = ((0, 0), (BLOCK, BLOCK), (0, 0), (0, 0))
    kp = jnp.pad(k, pad).reshape(b, nb + 2, BLOCK, hkv, d)
    vp = jnp.pad(v, pad).reshape(b, nb + 2, BLOCK, hkv, d)
    kb = jnp.concatenate([kp[:, :-2], kp[:, 1:-1], kp[:, 2:]], axis=2)
    vb = jnp.concatenate([vp[:, :-2], vp[:, 1:-1], vp[:, 2:]], axis=2)
    qb = q.reshape(b, nb, BLOCK, hkv, g, d)
    s_band = jnp.einsum('bnqhgd,bnkhd->bnhgqk', qb, kb).astype(jnp.float32) * scale
    qpos = jnp.arange(BLOCK)[:, None]
    kpos = jnp.arange(3 * BLOCK)[None, :] - BLOCK
    abs_k = (jnp.arange(nb) * BLOCK)[:, None, None] + kpos[None]
    valid = (jnp.abs(kpos - qpos) <= WINDOW)[None] & (abs_k >= 0) & (abs_k < s_len)
    s_band = jnp.where(valid[None, :, None, None], s_band, NEG_INF)
    s_ctx = jnp.einsum('bnqhgd,bkhd->bnhgqk', qb, k_ctx).astype(jnp.float32) * scale
    s_sink = jnp.broadcast_to(sink.astype(jnp.float32).reshape(1, 1, hkv, g, 1, 1), s_band.shape[:-1] + (1,))
    n_ctx = k_ctx.shape[1]
    p = jax.nn.softmax(jnp.concatenate([s_ctx, s_band, s_sink], axis=-1), axis=-1).astype(v.dtype)
    o = (jnp.einsum('bnhgqk,bkhd->bnqhgd', p[..., :n_ctx], v_ctx)
         + jnp.einsum('bnhgqk,bnkhd->bnqhgd', p[..., n_ctx:n_ctx + 3 * BLOCK], vb))
    return o.reshape(b, s_len, hq, d)


def mixer_a_qkv(p, rope):
    q, k, v = jnp.split(p, [A_HEADS * HEAD_DIM, (A_HEADS + A_KV_HEADS) * HEAD_DIM], axis=-1)
    q, k, v = split_heads(q, A_HEADS), split_heads(k, A_KV_HEADS), split_heads(v, A_KV_HEADS)
    if rope is not None:
        q, k = apply_rope(q, rope), apply_rope(k, rope)
    return q, k, v


def mixer_b_qkv(p, q_norm, w_uq, kv_norm, w_ukv, rope):
    cq, ckv, k_rope = jnp.split(p, [B_Q_RANK, B_Q_RANK + B_KV_RANK], axis=-1)
    q = split_heads(rmsnorm(cq, q_norm) @ w_uq, B_HEADS)
    kv = split_heads(rmsnorm(ckv, kv_norm) @ w_ukv, B_HEADS)
    q_nope, q_rope = q[..., :B_NOPE], q[..., B_NOPE:]
    k_nope, v = kv[..., :B_NOPE], kv[..., B_NOPE:]
    k_rope = k_rope[:, :, None, :]
    if rope is not None:
        q_rope, k_rope = apply_rope(q_rope, rope), apply_rope(k_rope, rope)
    k = jnp.concatenate([k_nope, jnp.broadcast_to(k_rope, k_nope.shape[:-1] + (B_ROPE,))], axis=-1)
    return jnp.concatenate([q_nope, q_rope], axis=-1), k, v


def mixer_c_qkv(p, rope):
    q, k, v = jnp.split(p, [2 * C_HEADS * C_QK, 4 * C_HEADS * C_QK], axis=-1)
    q, k = split_heads(q, 2 * C_HEADS), split_heads(k, 2 * C_HEADS)
    if rope is not None:
        q, k = apply_rope(q, rope), apply_rope(k, rope)
    v = jnp.repeat(split_heads(v, C_HEADS), 2, axis=2)
    return q, k, v


def diff_combine(o, lam_params, subln, layer):
    b, s_len = o.shape[:2]
    o = o.reshape(b, s_len, C_HEADS, 2, C_V)
    lam_init = 0.8 - 0.6 * math.exp(-0.3 * layer)
    lp = lam_params.astype(jnp.float32)
    lam = jnp.exp(jnp.sum(lp[0] * lp[1])) - jnp.exp(jnp.sum(lp[2] * lp[3])) + lam_init
    out = o[:, :, :, 0] - lam.astype(o.dtype) * o[:, :, :, 1]
    return merge_heads(rmsnorm(out, subln) * (1 - lam_init))


def mixer_d_qkv(p, q_norm, k_norm, rope):
    q, k, v = jnp.split(p, [D_HEADS * HEAD_DIM, (D_HEADS + D_KV_HEADS) * HEAD_DIM], axis=-1)
    q = rmsnorm(split_heads(q, D_HEADS), q_norm)
    k = rmsnorm(split_heads(k, D_KV_HEADS), k_norm)
    v = split_heads(v, D_KV_HEADS)
    if rope is not None:
        q, k = apply_rope(q, rope), apply_rope(k, rope)
    return q, k, v


def token_mixers(hl, hc, layer, with_ctx_out, w_in, a_sink, b_q_norm, b_w_uq, b_kv_norm, b_w_ukv,
                 c_lambda, c_subln, d_q_norm, d_k_norm, w_out, rope64, rope32):
    pa, pb, pc, pd = jnp.split(hl @ w_in, COL_SPLITS, axis=-1)
    ca, cb, cc, cd = jnp.split(hc @ w_in, COL_SPLITS, axis=-1)
    qa, ka, va = mixer_a_qkv(pa, rope64)
    qac, kac, vac = mixer_a_qkv(ca, None)
    qb, kb, vb = mixer_b_qkv(pb, b_q_norm, b_w_uq, b_kv_norm, b_w_ukv, rope32)
    qbc, kbc, vbc = mixer_b_qkv(cb, b_q_norm, b_w_uq, b_kv_norm, b_w_ukv, None)
    qc, kc, vc = mixer_c_qkv(pc, rope32)
    qcc, kcc, vcc = mixer_c_qkv(cc, None)
    qd, kd, vd = mixer_d_qkv(pd, d_q_norm, d_k_norm, rope64)
    qdc, kdc, vdc = mixer_d_qkv(cd, d_q_norm, d_k_norm, None)
    scale64 = HEAD_DIM ** -0.5
    scale_b = (B_NOPE + B_ROPE) ** -0.5
    scale_c = C_QK ** -0.5
    cat = lambda t_ctx, t_lat: jnp.concatenate([t_ctx, t_lat], axis=1)
    oa = window_attention_sink(qa, ka, va, kac, vac, a_sink, scale64)
    ob = dense_attention(qb, cat(kbc, kb), cat(vbc, vb), scale_b)
    oc = diff_combine(dense_attention(qc, cat(kcc, kc), cat(vcc, vc), scale_c), c_lambda, c_subln, layer)
    od = dense_attention(qd, cat(kdc, kd), cat(vdc, vd), scale64)
    out_lat = jnp.concatenate([merge_heads(oa), merge_heads(ob), oc, merge_heads(od)], axis=-1) @ w_out
    if not with_ctx_out:
        return out_lat, None
    oac = dense_attention(qac, kac, vac, scale64, sink=a_sink)
    obc = dense_attention(qbc, kbc, vbc, scale_b)
    occ = diff_combine(dense_attention(qcc, kcc, vcc, scale_c), c_lambda, c_subln, layer)
    odc = dense_attention(qdc, kdc, vdc, scale64)
    out_ctx = jnp.concatenate([merge_heads(oac), merge_heads(obc), occ, merge_heads(odc)], axis=-1) @ w_out
    return out_lat, out_ctx


def expert_choice_ffn(h, w_router, w_gate, w_up, w_down):
    b, n, d = h.shape
    cap = CAPACITY_FACTOR * n // N_EXPERTS
    logits = jnp.einsum('bnd,de->ben', h, w_router).astype(jnp.float32)
    affinity = jax.nn.softmax(logits, axis=1)
    gates, idx = lax.top_k(affinity, cap)
    xs = jax.vmap(lambda hb, ib: hb[ib])(h, idx)
    a = jnp.einsum('becd,edf->becf', xs, w_gate)
    u = jnp.einsum('becd,edf->becf', xs, w_up)
    y = jnp.einsum('becf,efd->becd', jax.nn.silu(a) * u, w_down) * gates[..., None].astype(h.dtype)
    return jax.vmap(lambda yb, ib: jnp.zeros((n, d), yb.dtype).at[ib.reshape(-1)].add(yb.reshape(-1, d)))(y, idx)


def setup_inputs(seed: int = 0) -> dict:
    key = jax.random.key(seed)
    ks = jax.random.split(key, 24)
    D, L = D_MODEL, DEPTH

    def nrm(i, shape, s):
        return jax.random.normal(ks[i], shape, jnp.float32) * s

    def gain(i, shape):
        return 1.0 + nrm(i, shape, 0.02)

    return {
        "x": nrm(0, (BATCH, SEQ, D), 1.0),
        "c": nrm(1, (BATCH, D), 1.0),
        "ctx": nrm(2, (BATCH, CTX_LEN, D), 1.0),
        "c_ctx": nrm(3, (D,), 1.0),
        "w_mod": nrm(4, (L, D, 6 * D), 0.5 * D ** -0.5),
        "b_mod": nrm(5, (L, 6 * D), 0.02),
        "g_attn": gain(6, (L, D)),
        "g_ffn": gain(7, (L, D)),
        "w_in": nrm(8, (L, D, IN_COLS), D ** -0.5),
        "a_sink": nrm(9, (L, A_HEADS), 0.5),
        "b_q_norm": gain(10, (L, B_Q_RANK)),
        "b_w_uq": nrm(11, (L, B_Q_RANK, B_HEADS * (B_NOPE + B_ROPE)), B_Q_RANK ** -0.5),
        "b_kv_norm": gain(12, (L, B_KV_RANK)),
        "b_w_ukv": nrm(13, (L, B_KV_RANK, B_HEADS * (B_NOPE + B_V)), B_KV_RANK ** -0.5),
        "c_lambda": nrm(14, (L, 4, C_QK), 0.1),
        "c_subln": gain(15, (L, C_V)),
        "d_q_norm": gain(16, (L, HEAD_DIM)),
        "d_k_norm": gain(17, (L, HEAD_DIM)),
        "w_out": nrm(18, (L, MIX_WIDTH, D), MIX_WIDTH ** -0.5),
        "w_router": nrm(19, (L, D, N_EXPERTS), D ** -0.5),
        "w_gate": nrm(20, (L, N_EXPERTS, D, D_EXPERT), D ** -0.5),
        "w_up": nrm(21, (L, N_EXPERTS, D, D_EXPERT), D ** -0.5),
        "w_down": nrm(22, (L, N_EXPERTS, D_EXPERT, D), D_EXPERT ** -0.5),
        "g_final": gain(23, (D,)),
    }


def reference(x, c, ctx, c_ctx, w_mod, b_mod, g_attn, g_ffn, w_in, a_sink, b_q_norm, b_w_uq,
              b_kv_norm, b_w_ukv, c_lambda, c_subln, d_q_norm, d_k_norm, w_out, w_router,
              w_gate, w_up, w_down, g_final):
    n_tokens = x.shape[1]
    rope64 = axial_rope_table(n_tokens, HEAD_DIM)
    rope32 = axial_rope_table(n_tokens, C_QK)
    xl, xc = x, ctx
    for l in range(DEPTH):
        last = l == DEPTH - 1
        sh_a, sc_a, gt_a, sh_f, sc_f, gt_f = adaln_params(c, w_mod[l], b_mod[l])
        csh_a, csc_a, cgt_a, csh_f, csc_f, cgt_f = adaln_params(c_ctx, w_mod[l], b_mod[l])
        hl = modulate(xl, g_attn[l], sh_a, sc_a)
        hc = modulate(xc, g_attn[l], csh_a, csc_a)
        out_lat, out_ctx = token_mixers(hl, hc, l, not last, w_in[l], a_sink[l], b_q_norm[l], b_w_uq[l],
                                        b_kv_norm[l], b_w_ukv[l], c_lambda[l], c_subln[l], d_q_norm[l],
                                        d_k_norm[l], w_out[l], rope64, rope32)
        xl = xl + gt_a * out_lat
        hl = modulate(xl, g_ffn[l], sh_f, sc_f)
        xl = xl + gt_f * expert_choice_ffn(hl, w_router[l], w_gate[l], w_up[l], w_down[l])
        if not last:
            xc = xc + cgt_a * out_ctx
            hc = modulate(xc, g_ffn[l], csh_f, csc_f)
            xc = xc + cgt_f * expert_choice_ffn(hc, w_router[l], w_gate[l], w_up[l], w_down[l])
    return rmsnorm(xl, g_final)
```

```cpp
#include <hip/hip_runtime.h>
#include <cstdio>
#include <cstdint>

#ifndef MK_LAUNCHES
#define MK_LAUNCHES 1
#endif

#ifndef DBGLAM
#define DBGLAM -100.f
#endif
#ifndef DBGCHK
#define DBGCHK 0
#endif
#define GAS __attribute__((address_space(1)))
#define LAS __attribute__((address_space(3)))
typedef unsigned short bf16_t;
typedef short bf16x8 __attribute__((ext_vector_type(8)));
typedef short s16x4 __attribute__((ext_vector_type(4)));
typedef float f32x4 __attribute__((ext_vector_type(4)));
typedef float f32x2 __attribute__((ext_vector_type(2)));
typedef float f32x16 __attribute__((ext_vector_type(16)));
typedef unsigned u32x4 __attribute__((ext_vector_type(4)));
typedef unsigned u32x2 __attribute__((ext_vector_type(2)));
typedef int i32x4 __attribute__((ext_vector_type(4)));
typedef int i32x8 __attribute__((ext_vector_type(8)));

constexpr int DM = 1024, NBATCH = 2, SEQ = 8192, CTXL = 256, DEPTH = 2;
constexpr int RB = SEQ + CTXL;
constexpr int NR = NBATCH * RB;
constexpr int INC = 2144, INCP = 2304;
constexpr int NEXP = 16, CAPL = 1024, CAPC = 32;
constexpr int YROWS = (128 + 16) * 256;
constexpr float EPS = 1e-6f;
constexpr float LOG2E = 1.4426950408889634f;
constexpr int PA_Q = 0, PA_K = 256, PA_V = 384;
constexpr int PB_CQ = 512, PB_CKV = 704, PB_KR = 832;
constexpr int PC_Q = 864, PC_K = 1120, PC_V = 1376;
constexpr int PD_Q = 1632, PD_K = 1888, PD_V = 2016;

constexpr size_t MiB = 1u << 20;
constexpr size_t WS_CTL = 0, CTL_ZERO_BYTES = 64 * 1024;
constexpr size_t WS_MOD   = 1 * MiB;
constexpr size_t WS_LAM   = WS_MOD + 160 * 1024;
constexpr size_t WS_TAB64 = WS_MOD + 192 * 1024;
constexpr size_t WS_TAB32 = WS_MOD + 224 * 1024;
constexpr size_t WS_RS    = WS_MOD + 256 * 1024;
constexpr size_t WS_GATEY = WS_MOD + 512 * 1024;
constexpr size_t WS_IDX   = WS_MOD + 768 * 1024;
constexpr size_t WS_AFF   = 2 * MiB;
constexpr size_t WS_SLOT  = 4 * MiB;
constexpr size_t WS_WIN   = 8 * MiB;
constexpr size_t WS_WOUT  = 18 * MiB;
constexpr size_t WS_WUQ   = 22 * MiB;
constexpr size_t WS_WGU   = 24 * MiB;
constexpr size_t WS_WDN   = 88 * MiB;
constexpr size_t WS_WL    = 96 * MiB;
constexpr size_t WS_X     = 216 * MiB;
constexpr size_t WS_H     = 282 * MiB;
constexpr size_t WS_PROJ  = 315 * MiB;
constexpr size_t WS_ATT   = 391 * MiB;
constexpr size_t WS_END   = 499 * MiB;
constexpr size_t AO_QA = 0, AO_KA = AO_QA + (size_t)NR * 256, AO_QBR = AO_KA + (size_t)NR * 128, AO_KVBR = AO_QBR + (size_t)NR * 512,
                 AO_QB = AO_KVBR + (size_t)NR * 512, AO_KB = AO_QB + (size_t)NR * 384, AO_VB = AO_KB + (size_t)NR * 384,
                 AO_QC = AO_VB + (size_t)NR * 256, AO_KC = AO_QC + (size_t)NR * 256, AO_QD = AO_KC + (size_t)NR * 256, AO_KD = AO_QD + (size_t)NR * 256,
                 AO_END = AO_KD + (size_t)NR * 128;
static_assert(WS_ATT + AO_END * 2 <= WS_END, "attention operands fit");
constexpr size_t WS_MIX = WS_ATT + AO_QBR * 2;
static_assert(AO_KVBR - AO_QBR == (size_t)NR * 512 && AO_QB - AO_KVBR == (size_t)NR * 512 && (WS_MIX % 16) == 0, "MIX overlay");
constexpr size_t WS_BGCNT = 40 * 1024;
static_assert((size_t)YROWS * 1024 * 2 <= WS_ATT - WS_PROJ && (size_t)YROWS * 1024 * 2 <= WS_END - WS_ATT, "ACT / Y overlays fit");

constexpr int RING_BYTES = 131072;
constexpr int GIDX_OFF = RING_BYTES;
constexpr int MISC_OFF = RING_BYTES + 8192;
constexpr int LDS_BYTES = 147456;
constexpr int NTHREADS = 512, NWAVES = 8;

#define LDS_WAIT() asm volatile("s_waitcnt lgkmcnt(0)" ::: "memory")
#define VM_WAIT() asm volatile("s_waitcnt vmcnt(0)" ::: "memory")
__device__ __forceinline__ unsigned f2bf(float f) { unsigned u = __builtin_bit_cast(unsigned, f); return (u + 0x7fffu + ((u >> 16) & 1u)) >> 16; }
__device__ __forceinline__ unsigned pk2(float lo, float hi) { return f2bf(lo) | (f2bf(hi) << 16); }
__device__ __forceinline__ float bf2f(unsigned h) { return __builtin_bit_cast(float, h << 16); }
__device__ __forceinline__ float bflo(unsigned w) { return __builtin_bit_cast(float, w << 16); }
__device__ __forceinline__ float bfhi(unsigned w) { return __builtin_bit_cast(float, w & 0xffff0000u); }
__device__ __forceinline__ float shx(float v, int o, int lane) { return __builtin_bit_cast(float, __builtin_amdgcn_ds_bpermute((lane ^ o) << 2, __builtin_bit_cast(int, v))); }
__device__ __forceinline__ int shxi(int v, int o, int lane) { return __builtin_amdgcn_ds_bpermute((lane ^ o) << 2, v); }
__device__ __forceinline__ int shidx(int v, int src) { return __builtin_amdgcn_ds_bpermute(src << 2, v); }
__device__ __forceinline__ float wave_sum(float v, int lane) {
#pragma unroll
    for (int o = 1; o < 64; o <<= 1) v += shx(v, o, lane);
    return v;
}
__device__ __forceinline__ float half_sum(float v, int lane) {
#pragma unroll
    for (int o = 1; o < 32; o <<= 1) v += shx(v, o, lane);
    return v;
}
constexpr float W8_MUL = 32.f;
constexpr int W8_SCALE = 0x7a7a7a7a, A8_SCALE = 0x7f7f7f7f;
__device__ __forceinline__ float clamp8(float x) { return __builtin_amdgcn_fmed3f(x, -448.f, 448.f); }
__device__ __forceinline__ unsigned pk4_fp8(float a, float b, float c, float d) { int w = 0; w = __builtin_amdgcn_cvt_pk_fp8_f32(clamp8(a), clamp8(b), w, false); w = __builtin_amdgcn_cvt_pk_fp8_f32(clamp8(c), clamp8(d), w, true); return (unsigned)w; }
__device__ __forceinline__ f32x4 ldx4(const bf16_t* p) { const u32x2 w = *(const u32x2*)p; return (f32x4){bflo(w.x), bfhi(w.x), bflo(w.y), bfhi(w.y)}; }
__device__ __forceinline__ void stx4(bf16_t* p, const f32x4& v) { u32x2 w; w.x = pk2(v.x, v.y); w.y = pk2(v.z, v.w); *(u32x2*)p = w; }
__device__ __forceinline__ float siluf(float x) { return x / (1.f + __expf(-x)); }
namespace pg8 {
constexpr int BM = 256, BK = 64, HALF = 128, HTB = HALF * BK * 2  , STAGE_BYTES = 8 * HTB, NXCD = 8, WGM = 8;

__host__ __device__ __forceinline__ int lds_byte(int r, int c) { const int st = (r >> 4) * 2 + (c >> 5), rr = r & 15, cc = c & 31, ob = rr * 64 + cc * 2; return st * 1024 + (ob ^ (((ob >> 9) & 1) << 5)); }
__host__ __device__ __forceinline__ void stage_rc(int b, int& R, int& C) { const int st = b / 1024, sb = b % 1024, swz = sb ^ (((sb >> 9) & 1) << 5); R = (st >> 1) * 16 + swz / 64; C = (st & 1) * 32 + (swz % 64) / 2; }
__host__ __device__ __forceinline__ int perm32(int rho) { const int n = rho >> 4, i = rho & 15; return 8 * (i >> 2) + 4 * n + (i & 3); }

struct Unit { int pm, pn, e; };
struct Gemm { const bf16_t* A; const bf16_t* Bt; int lda, ldb, K; const int* gidx; size_t bstride_e; size_t astride_e; };

struct Sched {
    int nM, nN, nwg, G, c, mode; unsigned mN;
    __device__ void init(int nM_, int nN_, int G_, int c_, int mode_) { nM = nM_; nN = nN_; nwg = nM * nN; G = G_; c = c_; mode = mode_; mN = 0xFFFFFFFFu / (unsigned)nN_ + 1u; }
    __device__ int units() const { return c < nwg ? (nwg - 1 - c) / G + 1 : 0; }
    __device__ int max_units() const { return (nwg + G - 1) / G; }
    __device__ bool next(int i, Unit& u) const {
        const long L = (long)i * G + c; if (L >= nwg) return false;
        int wgid = (int)L; { const int q = nwg / NXCD, r = nwg % NXCD, xcd = wgid % NXCD, off = wgid / NXCD; wgid = (xcd < r ? xcd * (q + 1) : r * (q + 1) + (xcd - r) * q) + off; }
        static_assert(WGM == 8, "shifts below");
        const int nig = WGM * nN, gid = (int)__umulhi((unsigned)(wgid >> 3), mN), rem = wgid - gid * nig, fm = gid * WGM, gsz = (nM - fm) < WGM ? (nM - fm) : WGM;
        int vm, pn_;
        if (gsz == WGM) { vm = fm + (rem & 7); pn_ = rem >> 3; } else { vm = fm + rem % gsz; pn_ = rem / gsz; }
        u.pn = pn_;
        int pm = vm, e = 0;
        if (mode == 1) pm = vm + 1 + (vm >= 32 ? 1 : 0);
        else if (mode == 2) { if (vm < 128) { pm = ((vm >> 2) & 1) * 64 + (vm >> 3) * 4 + (vm & 3); e = (pm >> 2) & 15; } else { pm = vm; e = vm - 128; } }
        else if (mode == 3) { e = vm / 66; pm = vm - e * 66; }
        else if (mode == 4) pm = vm * 33;
        u.pm = pm; u.e = e; return true;
    }
};

__device__ __forceinline__ unsigned cvt_pk_bf16(float lo, float hi) { unsigned r; asm volatile("v_cvt_pk_bf16_f32 %0, %1, %2" : "=v"(r) : "v"(lo), "v"(hi)); return r; }

struct EpiBf16 {
    static constexpr bool PERM = true;
    bf16_t* O; int ldc; size_t ostride_e;
    __device__ __forceinline__ void operator()(const f32x4 (&acc)[2][2][4][2], const Unit& u, int wr, int wc, int fr, int fq) const {
        const int row0 = u.pm * BM + wr * 64 + fr; const int col0 = u.pn * BM + wc * 32 + 8 * fq;
#pragma unroll
        for (int ai = 0; ai < 2; ++ai)
#pragma unroll
            for (int m = 0; m < 4; ++m) { bf16_t* rowp = O + (size_t)u.e * ostride_e + (size_t)(row0 + ai * HALF + m * 16) * ldc + col0;
#pragma unroll
                for (int bj = 0; bj < 2; ++bj) { const f32x4 v0 = acc[ai][bj][m][0], v1 = acc[ai][bj][m][1];
                    u32x4 w; w.x = cvt_pk_bf16(v0[0], v0[1]); w.y = cvt_pk_bf16(v0[2], v0[3]); w.z = cvt_pk_bf16(v1[0], v1[1]); w.w = cvt_pk_bf16(v1[2], v1[3]);
                    *(u32x4*)(rowp + bj * HALF) = w; } }
    }
};
struct EpiSwiGLU {
    static constexpr bool PERM = true;
    bf16_t* O; int ldc;
    __device__ __forceinline__ void operator()(const f32x4 (&acc)[2][2][4][2], const Unit& u, int wr, int wc, int fr, int fq) const {
        const int row0 = u.pm * BM + wr * 64 + fr; const int col0 = u.pn * HALF + wc * 32 + 8 * fq;
#pragma unroll
        for (int ai = 0; ai < 2; ++ai)
#pragma unroll
            for (int m = 0; m < 4; ++m) { bf16_t* rowp = O + (size_t)(row0 + ai * HALF + m * 16) * ldc + col0;
                float r[8];
#pragma unroll
                for (int n = 0; n < 2; ++n)
#pragma unroll
                    for (int j = 0; j < 4; ++j) { const float a = acc[ai][0][m][n][j], b = acc[ai][1][m][n][j]; r[n * 4 + j] = a * __builtin_amdgcn_rcpf(1.f + __builtin_amdgcn_exp2f(-a * LOG2E)) * b; }
                u32x4 w; w.x = cvt_pk_bf16(r[0], r[1]); w.y = cvt_pk_bf16(r[2], r[3]); w.z = cvt_pk_bf16(r[4], r[5]); w.w = cvt_pk_bf16(r[6], r[7]);
                *(u32x4*)rowp = w; }
    }
};
struct EpiSwiGLU8 {
    static constexpr bool PERM = true;
    unsigned char* O; int ldc;
    __device__ __forceinline__ void operator()(const f32x4 (&acc)[2][2][4][2], const Unit& u, int wr, int wc, int fr, int fq) const {
        const int row0 = u.pm * BM + wr * 64 + fr; const int col0 = u.pn * HALF + wc * 32 + 8 * fq;
#pragma unroll
        for (int ai = 0; ai < 2; ++ai)
#pragma unroll
            for (int m = 0; m < 4; ++m) { unsigned char* rowp = O + (size_t)(row0 + ai * HALF + m * 16) * ldc + col0;
                float r[8];
#pragma unroll
                for (int n = 0; n < 2; ++n)
#pragma unroll
                    for (int j = 0; j < 4; ++j) { const float a = acc[ai][0][m][n][j], b = acc[ai][1][m][n][j]; r[n * 4 + j] = a * __builtin_amdgcn_rcpf(1.f + __builtin_amdgcn_exp2f(-a * LOG2E)) * b; }
                u32x2 w; w.x = pk4_fp8(r[0], r[1], r[2], r[3]); w.y = pk4_fp8(r[4], r[5], r[6], r[7]);
                *(u32x2*)rowp = w; }
    }
};
struct EpiResid {
    static constexpr bool PERM = true;
    bf16_t* X; const float* gate; int gp; float dbg;
    __device__ __forceinline__ void operator()(const f32x4 (&acc)[2][2][4][2], const Unit& u, int wr, int wc, int fr, int fq) const {
        const int mr = (u.pm % 33 == 0) ? 2 : (u.pm / 33);
        const int col0 = u.pn * BM + wc * 32 + 8 * fq;
        f32x4 gv[2][2];
#pragma unroll
        for (int bj = 0; bj < 2; ++bj)
#pragma unroll
            for (int n = 0; n < 2; ++n) gv[bj][n] = *(const f32x4*)(gate + (size_t)mr * gp + col0 + bj * HALF + n * 4) * dbg;
#pragma unroll
        for (int ai = 0; ai < 2; ++ai)
#pragma unroll
            for (int m = 0; m < 4; ++m) { bf16_t* rowp = X + (size_t)(u.pm * BM + ai * HALF + wr * 64 + m * 16 + fr) * DM + col0;
                u32x4 xw[2];
#pragma unroll
                for (int bj = 0; bj < 2; ++bj) xw[bj] = *(const u32x4*)(rowp + bj * HALF);
#pragma unroll
                for (int bj = 0; bj < 2; ++bj) { const f32x4 a0 = acc[ai][bj][m][0], a1 = acc[ai][bj][m][1]; const u32x4 x = xw[bj]; u32x4 w;
                    w.x = cvt_pk_bf16(bflo(x.x) + gv[bj][0][0] * a0[0], bfhi(x.x) + gv[bj][0][1] * a0[1]); w.y = cvt_pk_bf16(bflo(x.y) + gv[bj][0][2] * a0[2], bfhi(x.y) + gv[bj][0][3] * a0[3]);
                    w.z = cvt_pk_bf16(bflo(x.z) + gv[bj][1][0] * a1[0], bfhi(x.z) + gv[bj][1][1] * a1[1]); w.w = cvt_pk_bf16(bflo(x.w) + gv[bj][1][2] * a1[2], bfhi(x.w) + gv[bj][1][3] * a1[3]);
                    *(u32x4*)(rowp + bj * HALF) = w; }
                asm volatile("" ::: "memory"); }
    }
};

__device__ __forceinline__ void mfma8(f32x4& acc, const i32x8 a, const i32x8 b, int sa, int sb) {
    asm volatile("v_mfma_scale_f32_16x16x128_f8f6f4 %0, %1, %2, %0, %3, %4 op_sel_hi:[0,0,0]" : "+v"(acc) : "v"(a), "v"(b), "v"(sa), "v"(sb));
}
template <class Epi, bool GATHER, bool FP8 = false>
__device__ __forceinline__ void gemm_phase(LAS unsigned char* lds, LAS int* gl, const Gemm g, const Sched& S, const Epi& E) {
    int tid_ = threadIdx.x; asm volatile("" : "+v"(tid_));
    const int tid = tid_, wid = __builtin_amdgcn_readfirstlane(tid >> 6), lane = tid & 63, wr = wid >> 2, wc = wid & 3, fr = lane & 15, fq = lane >> 4;
    const int K = g.K, nt = K / BK;
    int sc_w = W8_SCALE, sc_a = A8_SCALE; if constexpr (FP8) { asm volatile("" : "+v"(sc_w), "+v"(sc_a)); }
    int Rs[2], Cs[2]; unsigned voffB[2]; unsigned vAc[2][2], vAn[2][2];
#pragma unroll
    for (int i = 0; i < 2; ++i) { int R, C; stage_rc(tid * 16 + i * 8192, R, C); Rs[i] = R; Cs[i] = C; const int Rb = Epi::PERM ? ((R & ~31) + perm32(R & 31)) : R;
        voffB[i] = (unsigned)(Rb * g.ldb + C) * 2u;
#pragma unroll
        for (int h = 0; h < 2; ++h) { vAc[h][i] = (unsigned)((h * HALF + R) * g.lda + C) * 2u; vAn[h][i] = vAc[h][i]; } }
    const size_t kstep = (size_t)(BK * 2);
    const size_t hstepB = (size_t)HALF * g.ldb * 2;
    const unsigned ldsw = (unsigned)wid * 1024u;
    const int aoff = lds_byte(wr * 64 + fr, fq * 8), boff = lds_byte(wc * 32 + fr, fq * 8);
#define PG8_SA(b, h) (((b) * 2 + (h)) * HTB)
#define PG8_SB(b, h) ((4 + (b) * 2 + (h)) * HTB)
#define PG8_STAGE(bufoff, gbase, voff) do { _Pragma("unroll") for (int _i = 0; _i < 2; ++_i) \
        __builtin_amdgcn_global_load_lds((const unsigned*)((const char*)(gbase) + (voff)[_i]), (LAS unsigned*)(lds + (bufoff) + ldsw + _i * 8192), 16, 0, 0); } while (0)
#define PG8_LDA(dst, b, h) do { _Pragma("unroll") for (int m = 0; m < 4; ++m) _Pragma("unroll") for (int k = 0; k < 2; ++k) dst[m][k] = *(const LAS bf16x8*)(lds + PG8_SA(b, h) + aoff + m * 2048 + k * 1024); } while (0)
#define PG8_LDB(dst, b, h) do { _Pragma("unroll") for (int n = 0; n < 2; ++n) _Pragma("unroll") for (int k = 0; k < 2; ++k) dst[n][k] = *(const LAS bf16x8*)(lds + PG8_SB(b, h) + boff + n * 2048 + k * 1024); } while (0)
#define PG8_CAT(x) __builtin_shufflevector(__builtin_bit_cast(i32x4, x[0]), __builtin_bit_cast(i32x4, x[1]), 0, 1, 2, 3, 4, 5, 6, 7)
#define PG8_MMA(ai, bj, At, Bt) do { __builtin_amdgcn_s_setprio(1); _Pragma("unroll") for (int m = 0; m < 4; ++m) _Pragma("unroll") for (int n = 0; n < 2; ++n) { \
        if constexpr (FP8) mfma8(acc[ai][bj][m][n], PG8_CAT(Bt[n]), PG8_CAT(At[m]), sc_w, sc_a); \
        else { _Pragma("unroll") for (int k = 0; k < 2; ++k) acc[ai][bj][m][n] = __builtin_amdgcn_mfma_f32_16x16x32_bf16(Bt[n][k], At[m][k], acc[ai][bj][m][n], 0, 0, 0); } } __builtin_amdgcn_s_setprio(0); } while (0)
#define PG8_WAIT_V(n) asm volatile("s_waitcnt vmcnt(" #n ")" ::: "memory")
#define PG8_WAIT_L(n) asm volatile("s_waitcnt lgkmcnt(" #n ")" ::: "memory")
#define PG8_BAR __builtin_amdgcn_s_barrier()
#define PG8_SCHED __builtin_amdgcn_sched_barrier(0)
    Unit cur, nxt; int ui = 0;
    if (!S.next(0, cur)) return;
    if constexpr (GATHER) {
        int gv_[8];
#pragma unroll
        for (int i = 0; i < 8; ++i) { Unit uu; const bool ok = S.next(i, uu); gv_[i] = (ok && tid < 256) ? g.gidx[uu.pm * BM + tid] : 0; }
#pragma unroll
        for (int i = 0; i < 8; ++i) if (tid < 256) gl[i * 256 + tid] = gv_[i];
        __syncthreads();
#pragma unroll
        for (int h = 0; h < 2; ++h)
#pragma unroll
            for (int i = 0; i < 2; ++i) { vAc[h][i] = (unsigned)(gl[h * HALF + Rs[i]] * g.lda + Cs[i]) * 2u; vAn[h][i] = vAc[h][i]; }
    }
    f32x4 acc[2][2][4][2];
#pragma unroll
    for (int a = 0; a < 2; ++a)
#pragma unroll
        for (int b = 0; b < 2; ++b)
#pragma unroll
            for (int m = 0; m < 4; ++m)
#pragma unroll
                for (int n = 0; n < 2; ++n) acc[a][b][m][n] = (f32x4){0.f, 0.f, 0.f, 0.f};
    bf16x8 At[4][2], B0[2][2], B1[2][2];
    const char* cA = (const char*)g.A + (GATHER ? (size_t)0 : ((size_t)cur.pm * BM * g.lda + (size_t)cur.e * g.astride_e) * 2);
    const char* cB = (const char*)g.Bt + ((size_t)cur.e * g.bstride_e + (size_t)cur.pn * BM * g.ldb) * 2;
    PG8_STAGE(PG8_SB(0, 0), cB, voffB); PG8_STAGE(PG8_SB(0, 1), cB + hstepB, voffB); PG8_STAGE(PG8_SA(0, 0), cA, vAc[0]); PG8_STAGE(PG8_SA(0, 1), cA, vAc[1]);
    if (wr == 1) PG8_BAR;
    PG8_WAIT_V(2); PG8_BAR;
    PG8_STAGE(PG8_SB(1, 0), cB + kstep, voffB); PG8_STAGE(PG8_SA(1, 0), cA + kstep, vAc[0]); PG8_STAGE(PG8_SB(1, 1), cB + hstepB + kstep, voffB);
    PG8_WAIT_V(6); PG8_BAR;
    for (;;) {
        const bool has_next = S.next(ui + 1, nxt);
        const char* nA = has_next ? (const char*)g.A + (GATHER ? (size_t)0 : ((size_t)nxt.pm * BM * g.lda + (size_t)nxt.e * g.astride_e) * 2) : cA;
        const char* nB = has_next ? (const char*)g.Bt + ((size_t)nxt.e * g.bstride_e + (size_t)nxt.pn * BM * g.ldb) * 2 : cB;
        if constexpr (GATHER) { if (has_next) {
#pragma unroll
            for (int h = 0; h < 2; ++h)
#pragma unroll
                for (int i = 0; i < 2; ++i) vAn[h][i] = (unsigned)(gl[(ui + 1) * 256 + h * HALF + Rs[i]] * g.lda + Cs[i]) * 2u; } }
        for (int t = 0; t < nt; t += 2) {
            const bool last = (t == nt - 2);
            const char* a1 = cA + (size_t)(t + 1) * kstep;
            const char* a2 = last ? nA : cA + (size_t)(t + 2) * kstep; const char* b2 = last ? nB : cB + (size_t)(t + 2) * kstep;
            const char* a3 = a2 + kstep; const char* b3 = b2 + kstep;
            unsigned v2[2][2];
#pragma unroll
            for (int h = 0; h < 2; ++h)
#pragma unroll
                for (int i = 0; i < 2; ++i) v2[h][i] = GATHER ? (last ? vAn[h][i] : vAc[h][i]) : vAc[h][i];
            PG8_LDB(B0, 0, 0); PG8_LDB(B1, 0, 1); PG8_SCHED; PG8_LDA(At, 0, 0); PG8_STAGE(PG8_SA(1, 1), a1, vAc[1]);
            PG8_WAIT_V(8); PG8_WAIT_L(0); PG8_BAR; PG8_MMA(0, 0, At, B0); PG8_MMA(0, 1, At, B1); PG8_BAR; PG8_SCHED;
            PG8_LDA(At, 0, 1); PG8_STAGE(PG8_SB(0, 0), b2, voffB); PG8_STAGE(PG8_SB(0, 1), b2 + hstepB, voffB); PG8_STAGE(PG8_SA(0, 0), a2, v2[0]);
            PG8_WAIT_V(8); PG8_WAIT_L(0); PG8_BAR; PG8_MMA(1, 0, At, B0); PG8_MMA(1, 1, At, B1); PG8_BAR; PG8_SCHED;
            PG8_LDB(B0, 1, 0); PG8_LDB(B1, 1, 1); PG8_SCHED; PG8_LDA(At, 1, 0); PG8_STAGE(PG8_SA(0, 1), a2, v2[1]);
            PG8_WAIT_V(8); PG8_WAIT_L(0); PG8_BAR; PG8_MMA(0, 0, At, B0); PG8_MMA(0, 1, At, B1); PG8_BAR; PG8_SCHED;
            PG8_LDA(At, 1, 1); PG8_STAGE(PG8_SB(1, 0), b3, voffB); PG8_STAGE(PG8_SB(1, 1), b3 + hstepB, voffB); PG8_STAGE(PG8_SA(1, 0), a3, v2[0]);
            PG8_WAIT_V(8); PG8_WAIT_L(0); PG8_BAR; PG8_MMA(1, 0, At, B0); PG8_MMA(1, 1, At, B1); PG8_BAR; PG8_SCHED;
        }
        if constexpr (FP8) asm volatile("s_nop 15\n\ts_nop 15" ::: "memory");
        if (wr == 0) PG8_BAR;
        E(acc, cur, wr, wc, fr, fq);
        if (!has_next) break;
#pragma unroll
        for (int a = 0; a < 2; ++a)
#pragma unroll
            for (int b = 0; b < 2; ++b)
#pragma unroll
                for (int m = 0; m < 4; ++m)
#pragma unroll
                    for (int n = 0; n < 2; ++n) acc[a][b][m][n] = (f32x4){0.f, 0.f, 0.f, 0.f};
        cur = nxt; cA = nA; cB = nB; ++ui;
        if constexpr (GATHER) {
#pragma unroll
            for (int h = 0; h < 2; ++h)
#pragma unroll
                for (int i = 0; i < 2; ++i) vAc[h][i] = vAn[h][i]; }
        if (wr == 1) PG8_BAR;
    }
    PG8_WAIT_V(0);
    PG8_BAR;
#undef PG8_SA
#undef PG8_SB
#undef PG8_STAGE
#undef PG8_LDA
#undef PG8_LDB
#undef PG8_MMA
#undef PG8_CAT
#undef PG8_WAIT_V
#undef PG8_WAIT_L
#undef PG8_BAR
#undef PG8_SCHED
}
}
namespace att {
constexpr int KBUF = 12288, VBUF = 8192;
constexpr int TS = 1;
constexpr int L_K = 0, L_V = 2 * TS * KBUF, L_WS = L_V + 2 * TS * VBUF, L_OST = L_WS + NWAVES * 512, L_END = L_OST + NWAVES * 4096;
static_assert(L_END <= RING_BYTES, "attention scratch fits the ring region");
constexpr float THR = 8.f;
constexpr float NEGBIG = -1e30f;

__device__ __forceinline__ int crow(int r, int hi) { return (r & 3) + 8 * (r >> 2) + 4 * hi; }
__device__ __forceinline__ unsigned cvtpk(float lo, float hi) { typedef __bf16 bf16x2_t __attribute__((ext_vector_type(2))); f32x2 v = {lo, hi}; bf16x2_t b = __builtin_convertvector(v, bf16x2_t); return __builtin_bit_cast(unsigned, b); }
typedef short v4i16_t __attribute__((ext_vector_type(4)));
__device__ __forceinline__ s16x4 vtr(const LAS char* p) { return __builtin_bit_cast(s16x4, __builtin_amdgcn_ds_read_tr16_b64_v4i16((LAS v4i16_t*)p)); }

struct Desc {
    const bf16_t* Q; int qp, qo;
    const bf16_t* K; int kp, ko;
    const bf16_t* V; int vp, vo;
    bf16_t* O; int oo;
};

__device__ __forceinline__ float rowmax32(const f32x16& p0, const f32x16& p1) {
    float a = fmaxf(fmaxf(p0[0], p0[1]), p1[0]), b = fmaxf(fmaxf(p0[2], p0[3]), p1[1]); a = fmaxf(fmaxf(a, p1[2]), p1[3]);
#pragma unroll
    for (int r = 4; r < 16; r += 4) { a = fmaxf(fmaxf(a, p0[r]), p0[r + 1]); b = fmaxf(fmaxf(b, p0[r + 2]), p0[r + 3]); a = fmaxf(fmaxf(a, p1[r]), p1[r + 1]); b = fmaxf(fmaxf(b, p1[r + 2]), p1[r + 3]); }
    float m = fmaxf(a, b);
    auto rr = __builtin_amdgcn_permlane32_swap(__float_as_uint(m), __float_as_uint(m), false, false);
    return fmaxf(__uint_as_float(rr[0]), __uint_as_float(rr[1]));
}

template <int NMAP, int ND, bool AWIN, bool NOMAX = false>
__device__ __forceinline__ bool attn_unit(const Desc& D, int b, int hq, int hk, int hv, int qt0, int ntile, int wstart, bool win, float sink2,
                                          float lam, const float* subln, float omul, unsigned char* shm, bool dbg_noctx = false) {
    constexpr int TSL = (NMAP == 2) ? 1 : TS;
    constexpr int NCH = NMAP * ND * 2;
    constexpr int DKT = NMAP * ND * 16;
    int tid_ = threadIdx.x; asm volatile("" : "+v"(tid_));
    const int tid = tid_, lane = tid & 63, r32 = lane & 31, hi = lane >> 5; const int wid = __builtin_amdgcn_readfirstlane(tid >> 6);
    constexpr bool LMFMA = false;
    constexpr bool NEGM = (NMAP == 1) && !NOMAX;
    const size_t rowb = (size_t)b * RB;
    float* wsf0 = (float*)(shm + L_WS) + wid * 128;
    const bf16_t* ksrc0 = D.K + (rowb + (tid & 63)) * D.kp + D.ko + hk * DKT + (tid >> 6) * 8;
    const bf16_t* ksrc1 = ksrc0 + 64;
    const bf16_t* vsrc = D.V + (rowb + 16 * (wid & 3) + (lane >> 2)) * D.vp + D.vo + hv * 64 + (wid >> 2) * 32 + (lane & 3) * 8;
    const bool k1on = (NCH > 8) && (tid < (NCH - 8) * 64);
    bf16x8 qr[NMAP][ND];
    { const bf16_t* qrow = D.Q + (rowb + qt0 + wid * 32 + r32) * D.qp + D.qo + hq * DKT + hi * 8;
#pragma unroll
      for (int m = 0; m < NMAP; ++m)
#pragma unroll
          for (int d0 = 0; d0 < ND; ++d0) qr[m][d0] = *(const bf16x8*)(qrow + m * ND * 16 + d0 * 16); }
    float mhat[NMAP], lreg[NMAP]; f32x16 o[NMAP][2], negm[NEGM ? NMAP : 1], ol[LMFMA ? NMAP : 1];
    if constexpr (LMFMA) {
#pragma unroll
        for (int m = 0; m < NMAP; ++m) ol[m] = f32x16{}; }
    const bf16x8 ones8 = {0x3F80, 0x3F80, 0x3F80, 0x3F80, 0x3F80, 0x3F80, 0x3F80, 0x3F80};
#pragma unroll
    for (int m = 0; m < NMAP; ++m) { mhat[m] = 0.f; lreg[m] = 0.f; o[m][0] = f32x16{}; o[m][1] = f32x16{}; if (NEGM) negm[m] = f32x16{}; }
    const int qt = qt0 + wid * 32 + r32;
    const int vlane = ((lane >> 4) & 1) * 32 + (lane & 3) * 8 + (4 * hi + ((lane & 15) >> 2)) * 64;
    u32x4 kr0[TSL], kr1[TSL], vr[TSL];
#pragma unroll
    for (int q = 0; q < TSL; ++q) kr1[q] = u32x4{};
#define ATT_TILE(j) (dbg_noctx ? (wstart + (j)) : ((j) < 4 ? (j) : wstart + (j) - 4))
#define ATT_LOAD(st) do { _Pragma("unroll") for (int q_ = 0; q_ < TSL; ++q_) { const size_t ro_ = (size_t)ATT_TILE((st) * TSL + q_) * 64; kr0[q_] = *(const u32x4*)(ksrc0 + ro_ * D.kp); if (k1on) kr1[q_] = *(const u32x4*)(ksrc1 + ro_ * D.kp); vr[q_] = *(const u32x4*)(vsrc + ro_ * D.vp); } } while (0)
#define ATT_WRITE(buf) do { _Pragma("unroll") for (int q_ = 0; q_ < TSL; ++q_) { *(u32x4*)(shm + L_K + ((buf) * TSL + q_) * KBUF + tid * 16) = kr0[q_]; if (k1on) *(u32x4*)(shm + L_K + ((buf) * TSL + q_) * KBUF + 8192 + tid * 16) = kr1[q_]; *(u32x4*)(shm + L_V + ((buf) * TSL + q_) * VBUF + tid * 16) = vr[q_]; } } while (0)
    const int nstage = ntile / TSL;
    ATT_LOAD(0); ATT_WRITE(0);
    __syncthreads();
    if (nstage > 1) ATT_LOAD(1);
    for (int st = 0; st < nstage; ++st) {
        const int cur = st & 1;
#pragma unroll
      for (int q = 0; q < TSL; ++q) { const int j = st * TSL + q;
        const unsigned char* kb = shm + L_K + (cur * TSL + q) * KBUF;
        const LAS char* vb = (const LAS char*)(shm + L_V + (cur * TSL + q) * VBUF) + vlane;
        s16x4 vlo[8], vhi[8];
#pragma unroll
        for (int i = 0; i < 8; ++i) { vlo[i] = vtr(vb + (i >> 2) * 4096 + (i & 3) * 1024); vhi[i] = vtr(vb + (i >> 2) * 4096 + (i & 3) * 1024 + 512); }
        if constexpr (NMAP == 2 && NOMAX) {
            f32x16 sc[2][2]; bf16x8 kfr[2][ND][2];
#pragma unroll
            for (int m = 0; m < 2; ++m)
#pragma unroll
                for (int d0 = 0; d0 < ND; ++d0) { kfr[m][d0][0] = *(const bf16x8*)(kb + ((m * ND + d0) * 2 + hi) * 1024 + r32 * 16); kfr[m][d0][1] = *(const bf16x8*)(kb + ((m * ND + d0) * 2 + hi) * 1024 + 512 + r32 * 16); }
#pragma unroll
            for (int m = 0; m < 2; ++m) { sc[m][0] = f32x16{}; sc[m][1] = f32x16{};
#pragma unroll
                for (int d0 = 0; d0 < ND; ++d0) { sc[m][0] = __builtin_amdgcn_mfma_f32_32x32x16_bf16(kfr[m][d0][0], qr[m][d0], sc[m][0], 0, 0, 0); sc[m][1] = __builtin_amdgcn_mfma_f32_32x32x16_bf16(kfr[m][d0][1], qr[m][d0], sc[m][1], 0, 0, 0); } }
            u32x4 pwa[4], pwb[4]; float sa = 0.f, sb = 0.f;
#pragma unroll
            for (int r = 0; r < 16; ++r) { sc[0][0][r] = __builtin_amdgcn_exp2f(sc[0][0][r]); sc[0][1][r] = __builtin_amdgcn_exp2f(sc[0][1][r]); sa += sc[0][0][r] + sc[0][1][r]; }
#pragma unroll
            for (int q = 0; q < 2; ++q) {
                pwa[q]     = (u32x4){cvtpk(sc[0][0][8 * q], sc[0][0][8 * q + 1]), cvtpk(sc[0][0][8 * q + 2], sc[0][0][8 * q + 3]), cvtpk(sc[0][0][8 * q + 4], sc[0][0][8 * q + 5]), cvtpk(sc[0][0][8 * q + 6], sc[0][0][8 * q + 7])};
                pwa[2 + q] = (u32x4){cvtpk(sc[0][1][8 * q], sc[0][1][8 * q + 1]), cvtpk(sc[0][1][8 * q + 2], sc[0][1][8 * q + 3]), cvtpk(sc[0][1][8 * q + 4], sc[0][1][8 * q + 5]), cvtpk(sc[0][1][8 * q + 6], sc[0][1][8 * q + 7])}; }
#pragma unroll
            for (int ks = 0; ks < 4; ++ks) {
#pragma unroll
                for (int d0 = 0; d0 < 2; ++d0) {
                    const bf16x8 vf = (bf16x8){vlo[d0 * 4 + ks][0], vlo[d0 * 4 + ks][1], vlo[d0 * 4 + ks][2], vlo[d0 * 4 + ks][3], vhi[d0 * 4 + ks][0], vhi[d0 * 4 + ks][1], vhi[d0 * 4 + ks][2], vhi[d0 * 4 + ks][3]};
                    o[0][d0] = __builtin_amdgcn_mfma_f32_32x32x16_bf16(__builtin_bit_cast(bf16x8, pwa[ks]), vf, o[0][d0], 0, 0, 0); }
                { const int hf = ks >> 1, q = ks & 1;
#pragma unroll
                  for (int r = 8 * q; r < 8 * q + 8; ++r) { sc[1][hf][r] = __builtin_amdgcn_exp2f(sc[1][hf][r]); sb += sc[1][hf][r]; }
                  pwb[2 * hf + q] = (u32x4){cvtpk(sc[1][hf][8 * q], sc[1][hf][8 * q + 1]), cvtpk(sc[1][hf][8 * q + 2], sc[1][hf][8 * q + 3]), cvtpk(sc[1][hf][8 * q + 4], sc[1][hf][8 * q + 5]), cvtpk(sc[1][hf][8 * q + 6], sc[1][hf][8 * q + 7])}; }
            }
#pragma unroll
            for (int ks = 0; ks < 4; ++ks)
#pragma unroll
                for (int d0 = 0; d0 < 2; ++d0) {
                    const bf16x8 vf = (bf16x8){vlo[d0 * 4 + ks][0], vlo[d0 * 4 + ks][1], vlo[d0 * 4 + ks][2], vlo[d0 * 4 + ks][3], vhi[d0 * 4 + ks][0], vhi[d0 * 4 + ks][1], vhi[d0 * 4 + ks][2], vhi[d0 * 4 + ks][3]};
                    o[1][d0] = __builtin_amdgcn_mfma_f32_32x32x16_bf16(__builtin_bit_cast(bf16x8, pwb[ks]), vf, o[1][d0], 0, 0, 0); }
            lreg[0] += sa; lreg[1] += sb;
        } else
#pragma unroll
        for (int m = 0; m < NMAP; ++m) {
            f32x16 p0, p1; if constexpr (NEGM) { p0 = negm[m]; p1 = negm[m]; } else { p0 = f32x16{}; p1 = f32x16{}; }
            bf16x8 kfr[ND][2];
#pragma unroll
            for (int d0 = 0; d0 < ND; ++d0) { kfr[d0][0] = *(const bf16x8*)(kb + ((m * ND + d0) * 2 + hi) * 1024 + r32 * 16); kfr[d0][1] = *(const bf16x8*)(kb + ((m * ND + d0) * 2 + hi) * 1024 + 512 + r32 * 16); }
#pragma unroll
            for (int d0 = 0; d0 < ND; ++d0) {
                p0 = __builtin_amdgcn_mfma_f32_32x32x16_bf16(kfr[d0][0], qr[m][d0], p0, 0, 0, 0);
                p1 = __builtin_amdgcn_mfma_f32_32x32x16_bf16(kfr[d0][1], qr[m][d0], p1, 0, 0, 0);
            }
            if constexpr (AWIN) { if (win && (dbg_noctx || j >= 4)) {
                const int kt0 = ATT_TILE(j) * 64 + 4 * hi - qt;
#pragma unroll
                for (int r = 0; r < 16; ++r) { const int dd = kt0 + (r & 3) + 8 * (r >> 2); if (dd < -128 || dd > 128) p0[r] = NEGBIG; if (dd + 32 < -128 || dd + 32 > 128) p1[r] = NEGBIG; } } }
            float rm = 0.f;
            if constexpr (!NOMAX) { rm = rowmax32(p0, p1); if constexpr (!NEGM) rm -= mhat[m]; }
            if (!NOMAX && (j == 0 || __any(rm > THR))) {
                const float dl = (j == 0) ? rm : fmaxf(rm, 0.f);
                mhat[m] += dl;
                if constexpr (NEGM) {
#pragma unroll
                    for (int r = 0; r < 16; ++r) { p0[r] -= dl; p1[r] -= dl; }
#pragma unroll
                    for (int r = 0; r < 16; ++r) negm[m][r] = -mhat[m];
                }
                if (j > 0) { float* wsf = wsf0 + m * 64; const float f = __builtin_amdgcn_exp2f(-dl); lreg[m] *= f; if (hi == 0) wsf[r32] = f;
                    LDS_WAIT();
#pragma unroll
                    for (int d_ = 0; d_ < 2; ++d_)
#pragma unroll
                        for (int r = 0; r < 16; ++r) o[m][d_][r] *= wsf[crow(r, hi)];
                    LDS_WAIT(); }
            }
            float sacc = 0.f;
#pragma unroll
            for (int r = 0; r < 16; ++r) { if constexpr (!NEGM && !NOMAX) { p0[r] -= mhat[m]; p1[r] -= mhat[m]; } p0[r] = __builtin_amdgcn_exp2f(p0[r]); p1[r] = __builtin_amdgcn_exp2f(p1[r]); if constexpr (!LMFMA) sacc += p0[r] + p1[r]; }
            lreg[m] += sacc;
            u32x4 pw[4];
#pragma unroll
            for (int s = 0; s < 2; ++s) {
                pw[s]     = (u32x4){cvtpk(p0[8 * s], p0[8 * s + 1]), cvtpk(p0[8 * s + 2], p0[8 * s + 3]), cvtpk(p0[8 * s + 4], p0[8 * s + 5]), cvtpk(p0[8 * s + 6], p0[8 * s + 7])};
                pw[2 + s] = (u32x4){cvtpk(p1[8 * s], p1[8 * s + 1]), cvtpk(p1[8 * s + 2], p1[8 * s + 3]), cvtpk(p1[8 * s + 4], p1[8 * s + 5]), cvtpk(p1[8 * s + 6], p1[8 * s + 7])};
            }
#pragma unroll
            for (int d0 = 0; d0 < 2; ++d0)
#pragma unroll
                for (int ks = 0; ks < 4; ++ks) {
                    const bf16x8 vf = (bf16x8){vlo[d0 * 4 + ks][0], vlo[d0 * 4 + ks][1], vlo[d0 * 4 + ks][2], vlo[d0 * 4 + ks][3], vhi[d0 * 4 + ks][0], vhi[d0 * 4 + ks][1], vhi[d0 * 4 + ks][2], vhi[d0 * 4 + ks][3]};
                    o[m][d0] = __builtin_amdgcn_mfma_f32_32x32x16_bf16(__builtin_bit_cast(bf16x8, pw[ks]), vf, o[m][d0], 0, 0, 0);
                }
            if constexpr (LMFMA) {
#pragma unroll
                for (int ks = 0; ks < 4; ++ks) ol[m] = __builtin_amdgcn_mfma_f32_32x32x16_bf16(__builtin_bit_cast(bf16x8, pw[ks]), ones8, ol[m], 0, 0, 0); }
        }
      }
        if (st + 1 < nstage) ATT_WRITE(cur ^ 1);
        __syncthreads();
        if (st + 2 < nstage) ATT_LOAD(st + 2);
    }
#undef ATT_TILE
#undef ATT_LOAD
#undef ATT_WRITE
    float rli[NMAP][16]; float lfin[NMAP];
    if constexpr (LMFMA) {
        bool bad = false;
#pragma unroll
        for (int m = 0; m < NMAP; ++m)
#pragma unroll
            for (int r = 0; r < 16; ++r) { const float l = ol[m][r]; bad = bad || !(l > 1e-30f && l < 1e30f); rli[m][r] = 1.f / l; }
        if (__syncthreads_or(bad ? 1 : 0)) return true;
    } else {
#pragma unroll
    for (int m = 0; m < NMAP; ++m) {
        float l = lreg[m];
        { auto rr = __builtin_amdgcn_permlane32_swap(__float_as_uint(l), __float_as_uint(l), false, false); l = __uint_as_float(rr[0]) + __uint_as_float(rr[1]); }
        if constexpr (AWIN) l += __builtin_amdgcn_exp2f(sink2 - mhat[m]);
        lfin[m] = l; }
    if constexpr (NOMAX) { bool bad = false;
#pragma unroll
        for (int m = 0; m < NMAP; ++m) bad = bad || !(lfin[m] > 1e-30f && lfin[m] < 1e30f);
        if (__syncthreads_or(bad ? 1 : 0)) return true; }
#pragma unroll
    for (int m = 0; m < NMAP; ++m) {
        const float l = lfin[m];
        float* wsf = wsf0 + m * 64;
        if (hi == 0) wsf[32 + r32] = 1.f / l;
        LDS_WAIT();
#pragma unroll
        for (int r = 0; r < 16; ++r) rli[m][r] = wsf[32 + crow(r, hi)];
        LDS_WAIT();
    }
    }
    bf16_t* stg = (bf16_t*)(shm + L_OST) + wid * 2048;
    if constexpr (NMAP == 2) {
        const float g0 = subln[r32] * omul, g1 = subln[32 + r32] * omul;
#pragma unroll
        for (int r = 0; r < 16; ++r) {
            const float d0v = o[0][0][r] * rli[0][r] - lam * (o[1][0][r] * rli[1][r]);
            const float d1v = o[0][1][r] * rli[0][r] - lam * (o[1][1][r] * rli[1][r]);
            const float ss = half_sum(d0v * d0v + d1v * d1v, lane);
            const float rs = rsqrtf(ss * (1.f / 64.f) + EPS);
            const int orow = crow(r, hi);
            stg[orow * 64 + r32] = (bf16_t)f2bf(d0v * rs * g0); stg[orow * 64 + 32 + r32] = (bf16_t)f2bf(d1v * rs * g1);
        }
    } else {
#pragma unroll
        for (int r = 0; r < 16; ++r) { const int orow = crow(r, hi);
            stg[orow * 64 + r32] = (bf16_t)f2bf(o[0][0][r] * rli[0][r] * omul); stg[orow * 64 + 32 + r32] = (bf16_t)f2bf(o[0][1][r] * rli[0][r] * omul); }
    }
    bf16_t* Ow = D.O + (rowb + qt0 + wid * 32) * DM + D.oo + hq * 64;
#pragma unroll
    for (int i = 0; i < 4; ++i) { const int row = i * 8 + (lane >> 3), ch = lane & 7; const u32x4 v = *(const u32x4*)(stg + row * 64 + ch * 8); *(u32x4*)(Ow + (size_t)row * DM + ch * 8) = v; }
    __syncthreads();
    return false;
}

template <int V> struct IC { static constexpr int value = V; };
template <int NMAP, int ND, bool AWIN, bool NOMAX = false>
__device__ __forceinline__ bool attn_unit_d(const Desc& D, int b, int hq, int hk, int hv, int qt0, int ntile, int wstart, bool win, float sink2,
                                          float lam, const float* subln, float omul, unsigned char* shm, bool dbg_noctx = false) {
    constexpr int TSL = (NMAP == 2) ? 1 : TS;
    constexpr int NCH = NMAP * ND * 2;
    constexpr int DKT = NMAP * ND * 16;
    int tid_ = threadIdx.x; asm volatile("" : "+v"(tid_));
    const int tid = tid_, lane = tid & 63, r32 = lane & 31, hi = lane >> 5; const int wid = __builtin_amdgcn_readfirstlane(tid >> 6);
    constexpr bool LMFMA = false;
    constexpr bool NEGM = (NMAP == 1) && !NOMAX;
    const size_t rowb = (size_t)b * RB;
    float* wsf0 = (float*)(shm + L_WS) + wid * 128;
    const bf16_t* ksrc0 = D.K + (rowb + (tid & 63)) * D.kp + D.ko + hk * DKT + (tid >> 6) * 8;
    const bf16_t* ksrc1 = ksrc0 + 64;
    const bf16_t* vsrc = D.V + (rowb + 16 * (wid & 3) + (lane >> 2)) * D.vp + D.vo + hv * 64 + (wid >> 2) * 32 + (lane & 3) * 8;
    const bool k1on = (NCH > 8) && (tid < (NCH - 8) * 64);
    bf16x8 qr[NMAP][ND];
    { const bf16_t* qrow = D.Q + (rowb + qt0 + wid * 32 + r32) * D.qp + D.qo + hq * DKT + hi * 8;
#pragma unroll
      for (int m = 0; m < NMAP; ++m)
#pragma unroll
          for (int d0 = 0; d0 < ND; ++d0) qr[m][d0] = *(const bf16x8*)(qrow + m * ND * 16 + d0 * 16); }
    float mhat[NMAP], lreg[NMAP]; f32x16 o[NMAP][2], negm[NEGM ? NMAP : 1], ol[LMFMA ? NMAP : 1];
    if constexpr (LMFMA) {
#pragma unroll
        for (int m = 0; m < NMAP; ++m) ol[m] = f32x16{}; }
    const bf16x8 ones8 = {0x3F80, 0x3F80, 0x3F80, 0x3F80, 0x3F80, 0x3F80, 0x3F80, 0x3F80};
#pragma unroll
    for (int m = 0; m < NMAP; ++m) { mhat[m] = 0.f; lreg[m] = 0.f; o[m][0] = f32x16{}; o[m][1] = f32x16{}; if (NEGM) negm[m] = f32x16{}; }
    const int qt = qt0 + wid * 32 + r32;
    const int vlane = ((lane >> 4) & 1) * 32 + (lane & 3) * 8 + (4 * hi + ((lane & 15) >> 2)) * 64;
    u32x4 kr0[2], kr1[2], vr[2];
#pragma unroll
    for (int q = 0; q < 2; ++q) kr1[q] = u32x4{};
#define ATT_TILE(j) (dbg_noctx ? (wstart + (j)) : ((j) < 4 ? (j) : wstart + (j) - 4))
#define ATT_LOAD(j, S) do { const size_t ro_ = (size_t)ATT_TILE(j) * 64; kr0[S] = *(const u32x4*)(ksrc0 + ro_ * D.kp); if (k1on) kr1[S] = *(const u32x4*)(ksrc1 + ro_ * D.kp); vr[S] = *(const u32x4*)(vsrc + ro_ * D.vp); } while (0)
#define ATT_WRITE(buf, S) do { *(u32x4*)(shm + L_K + (buf) * KBUF + tid * 16) = kr0[S]; if (k1on) *(u32x4*)(shm + L_K + (buf) * KBUF + 8192 + tid * 16) = kr1[S]; *(u32x4*)(shm + L_V + (buf) * VBUF + tid * 16) = vr[S]; } while (0)
#define ATT_BAR() do { asm volatile("s_waitcnt lgkmcnt(0)" ::: "memory"); __builtin_amdgcn_s_barrier(); asm volatile("" ::: "memory"); } while (0)
    constexpr bool DEEP = (NMAP == 1);
    ATT_LOAD(0, 0); ATT_WRITE(0, 0);
    ATT_BAR();
    if constexpr (DEEP) { if (ntile > 1) ATT_LOAD(1, 1); if (ntile > 2) ATT_LOAD(2, 0); } else { if (ntile > 1) ATT_LOAD(1, 0); }
    auto do_tile = [&](const int j, const int cur, auto setc) __attribute__((always_inline)) {
        constexpr int WSET = DEEP ? (decltype(setc)::value ^ 1) : 0;
        const unsigned char* kb = shm + L_K + cur * KBUF;
        const LAS char* vb = (const LAS char*)(shm + L_V + cur * VBUF) + vlane;
        s16x4 vlo[8], vhi[8];
#pragma unroll
        for (int i = 0; i < 8; ++i) { vlo[i] = vtr(vb + (i >> 2) * 4096 + (i & 3) * 1024); vhi[i] = vtr(vb + (i >> 2) * 4096 + (i & 3) * 1024 + 512); }
#pragma unroll
        for (int m = 0; m < NMAP; ++m) {
            f32x16 p0, p1; if constexpr (NEGM) { p0 = negm[m]; p1 = negm[m]; } else { p0 = f32x16{}; p1 = f32x16{}; }
            bf16x8 kfr[ND][2];
#pragma unroll
            for (int d0 = 0; d0 < ND; ++d0) { kfr[d0][0] = *(const bf16x8*)(kb + ((m * ND + d0) * 2 + hi) * 1024 + r32 * 16); kfr[d0][1] = *(const bf16x8*)(kb + ((m * ND + d0) * 2 + hi) * 1024 + 512 + r32 * 16); }
#pragma unroll
            for (int d0 = 0; d0 < ND; ++d0) {
                p0 = __builtin_amdgcn_mfma_f32_32x32x16_bf16(kfr[d0][0], qr[m][d0], p0, 0, 0, 0);
                p1 = __builtin_amdgcn_mfma_f32_32x32x16_bf16(kfr[d0][1], qr[m][d0], p1, 0, 0, 0);
            }
            if constexpr (AWIN) { if (win && (dbg_noctx || j >= 4)) {
                const int kt0 = ATT_TILE(j) * 64 + 4 * hi - qt;
#pragma unroll
                for (int r = 0; r < 16; ++r) { const int dd = kt0 + (r & 3) + 8 * (r >> 2); if (dd < -128 || dd > 128) p0[r] = NEGBIG; if (dd + 32 < -128 || dd + 32 > 128) p1[r] = NEGBIG; } } }
            float rm = 0.f;
            if constexpr (!NOMAX) { rm = rowmax32(p0, p1); if constexpr (!NEGM) rm -= mhat[m]; }
            if (!NOMAX && (j == 0 || __any(rm > THR))) {
                const float dl = (j == 0) ? rm : fmaxf(rm, 0.f);
                mhat[m] += dl;
                if constexpr (NEGM) {
#pragma unroll
                    for (int r = 0; r < 16; ++r) { p0[r] -= dl; p1[r] -= dl; }
#pragma unroll
                    for (int r = 0; r < 16; ++r) negm[m][r] = -mhat[m];
                }
                if (j > 0) { float* wsf = wsf0 + m * 64; const float f = __builtin_amdgcn_exp2f(-dl); lreg[m] *= f; if (hi == 0) wsf[r32] = f;
                    LDS_WAIT();
#pragma unroll
                    for (int d_ = 0; d_ < 2; ++d_)
#pragma unroll
                        for (int r = 0; r < 16; ++r) o[m][d_][r] *= wsf[crow(r, hi)];
                    LDS_WAIT(); }
            }
            float sacc = 0.f;
#pragma unroll
            for (int r = 0; r < 16; ++r) { if constexpr (!NEGM && !NOMAX) { p0[r] -= mhat[m]; p1[r] -= mhat[m]; } p0[r] = __builtin_amdgcn_exp2f(p0[r]); p1[r] = __builtin_amdgcn_exp2f(p1[r]); if constexpr (!LMFMA) sacc += p0[r] + p1[r]; }
            lreg[m] += sacc;
            u32x4 pw[4];
#pragma unroll
            for (int s = 0; s < 2; ++s) {
                pw[s]     = (u32x4){cvtpk(p0[8 * s], p0[8 * s + 1]), cvtpk(p0[8 * s + 2], p0[8 * s + 3]), cvtpk(p0[8 * s + 4], p0[8 * s + 5]), cvtpk(p0[8 * s + 6], p0[8 * s + 7])};
                pw[2 + s] = (u32x4){cvtpk(p1[8 * s], p1[8 * s + 1]), cvtpk(p1[8 * s + 2], p1[8 * s + 3]), cvtpk(p1[8 * s + 4], p1[8 * s + 5]), cvtpk(p1[8 * s + 6], p1[8 * s + 7])};
            }
#pragma unroll
            for (int d0 = 0; d0 < 2; ++d0)
#pragma unroll
                for (int ks = 0; ks < 4; ++ks) {
                    const bf16x8 vf = (bf16x8){vlo[d0 * 4 + ks][0], vlo[d0 * 4 + ks][1], vlo[d0 * 4 + ks][2], vlo[d0 * 4 + ks][3], vhi[d0 * 4 + ks][0], vhi[d0 * 4 + ks][1], vhi[d0 * 4 + ks][2], vhi[d0 * 4 + ks][3]};
                    o[m][d0] = __builtin_amdgcn_mfma_f32_32x32x16_bf16(__builtin_bit_cast(bf16x8, pw[ks]), vf, o[m][d0], 0, 0, 0);
                }
            if constexpr (LMFMA) {
#pragma unroll
                for (int ks = 0; ks < 4; ++ks) ol[m] = __builtin_amdgcn_mfma_f32_32x32x16_bf16(__builtin_bit_cast(bf16x8, pw[ks]), ones8, ol[m], 0, 0, 0); }
        }
        if (j + 1 < ntile) ATT_WRITE(cur ^ 1, WSET);
        ATT_BAR();
        if constexpr (DEEP) { if (j + 3 < ntile) ATT_LOAD(j + 3, WSET); } else { if (j + 2 < ntile) ATT_LOAD(j + 2, 0); }
    };
    if constexpr (DEEP) { for (int j = 0; j < ntile; j += 2) { do_tile(j, 0, IC<0>{}); do_tile(j + 1, 1, IC<1>{}); } }
    else { for (int j = 0; j < ntile; ++j) do_tile(j, j & 1, IC<0>{}); }
#undef ATT_TILE
#undef ATT_LOAD
#undef ATT_WRITE
#undef ATT_BAR
    float rli[NMAP][16]; float lfin[NMAP];
    if constexpr (LMFMA) {
        bool bad = false;
#pragma unroll
        for (int m = 0; m < NMAP; ++m)
#pragma unroll
            for (int r = 0; r < 16; ++r) { const float l = ol[m][r]; bad = bad || !(l > 1e-30f && l < 1e30f); rli[m][r] = 1.f / l; }
        if (__syncthreads_or(bad ? 1 : 0)) return true;
    } else {
#pragma unroll
    for (int m = 0; m < NMAP; ++m) {
        float l = lreg[m];
        { auto rr = __builtin_amdgcn_permlane32_swap(__float_as_uint(l), __float_as_uint(l), false, false); l = __uint_as_float(rr[0]) + __uint_as_float(rr[1]); }
        if constexpr (AWIN) l += __builtin_amdgcn_exp2f(sink2 - mhat[m]);
        lfin[m] = l; }
    if constexpr (NOMAX) { bool bad = false;
#pragma unroll
        for (int m = 0; m < NMAP; ++m) bad = bad || !(lfin[m] > 1e-30f && lfin[m] < 1e30f);
        if (__syncthreads_or(bad ? 1 : 0)) return true; }
#pragma unroll
    for (int m = 0; m < NMAP; ++m) {
        const float l = lfin[m];
        float* wsf = wsf0 + m * 64;
        if (hi == 0) wsf[32 + r32] = 1.f / l;
        LDS_WAIT();
#pragma unroll
        for (int r = 0; r < 16; ++r) rli[m][r] = wsf[32 + crow(r, hi)];
        LDS_WAIT();
    }
    }
    bf16_t* stg = (bf16_t*)(shm + L_OST) + wid * 2048;
    if constexpr (NMAP == 2) {
        const float g0 = subln[r32] * omul, g1 = subln[32 + r32] * omul;
#pragma unroll
        for (int r = 0; r < 16; ++r) {
            const float d0v = o[0][0][r] * rli[0][r] - lam * (o[1][0][r] * rli[1][r]);
            const float d1v = o[0][1][r] * rli[0][r] - lam * (o[1][1][r] * rli[1][r]);
            const float ss = half_sum(d0v * d0v + d1v * d1v, lane);
            const float rs = rsqrtf(ss * (1.f / 64.f) + EPS);
            const int orow = crow(r, hi);
            stg[orow * 64 + r32] = (bf16_t)f2bf(d0v * rs * g0); stg[orow * 64 + 32 + r32] = (bf16_t)f2bf(d1v * rs * g1);
        }
    } else {
#pragma unroll
        for (int r = 0; r < 16; ++r) { const int orow = crow(r, hi);
            stg[orow * 64 + r32] = (bf16_t)f2bf(o[0][0][r] * rli[0][r] * omul); stg[orow * 64 + 32 + r32] = (bf16_t)f2bf(o[0][1][r] * rli[0][r] * omul); }
    }
    bf16_t* Ow = D.O + (rowb + qt0 + wid * 32) * DM + D.oo + hq * 64;
#pragma unroll
    for (int i = 0; i < 4; ++i) { const int row = i * 8 + (lane >> 3), ch = lane & 7; const u32x4 v = *(const u32x4*)(stg + row * 64 + ch * 8); *(u32x4*)(Ow + (size_t)row * DM + ch * 8) = v; }
    __syncthreads();
    return false;
}

}
typedef const __attribute__((address_space(4))) unsigned char* kaptr_t;
struct Args { kaptr_t ka; float* out; unsigned char* ws; int lo, hi; };
enum { I_X = 0, I_C, I_CTX, I_CCTX, I_WMOD, I_BMOD, I_GATTN, I_GFFN, I_WIN, I_ASINK, I_BQN, I_BWUQ, I_BKVN, I_BWUKV, I_CLAM, I_CSUBLN, I_DQN, I_DKN, I_WOUT, I_WROUTER,
       I_WGATE, I_WUP, I_WDOWN, I_GFINAL };

__device__ __forceinline__ const float* arg_in(const Args& a, int i) { const GAS float* p = *(const GAS float* const __attribute__((address_space(4)))*)(a.ka + 8 * i); return (const float*)p; }
struct TI { int tid, lane, wave, gw, ngw, gtid, ngt; };
__device__ __forceinline__ TI mk_ti() {
    int t = threadIdx.x; asm volatile("" : "+v"(t));
    TI r; r.tid = t; r.lane = t & 63; r.wave = __builtin_amdgcn_readfirstlane(t >> 6);
    r.gw = blockIdx.x * NWAVES + r.wave; r.ngw = gridDim.x * NWAVES; r.gtid = blockIdx.x * NTHREADS + t; r.ngt = gridDim.x * NTHREADS; return r;
}

#define XB_TMO      128
#define XB_XCNT(j)  (256  + 64 * (j))
#define XB_XSUB(j)  (1280 + 64 * (j))
#define XB_XGEN(j)  (2304 + 64 * (j))
#define XB_TOP      3328
#define XB_TOPGEN   3392
#define XCD_BAR_WORDS 3456
#define XB_SPIN_CAP (1u << 20)
__device__ __forceinline__ unsigned xb_ld(unsigned* p)              { return __hip_atomic_load(p, __ATOMIC_RELAXED, __HIP_MEMORY_SCOPE_AGENT); }
__device__ __forceinline__ unsigned xb_add(unsigned* p, unsigned v) { return __hip_atomic_fetch_add(p, v, __ATOMIC_RELAXED, __HIP_MEMORY_SCOPE_AGENT); }
__device__ __forceinline__ unsigned xb_xcc_id() { return (unsigned)__builtin_amdgcn_s_getreg((3 << 11) | 20) & 0xFu; }
#define XB_SPIN(cond, bar) do { unsigned _sp = 0; while (cond) { __builtin_amdgcn_s_sleep(1); \
    if ((++_sp & 255u) == 0u) { if (xb_ld(&(bar)[XB_TMO])) break; if (_sp > XB_SPIN_CAP) { atomicAdd(&(bar)[XB_TMO], 1u); break; } } } } while (0)
struct XcdBarrier { unsigned* bar; unsigned x; volatile LAS unsigned* st; };
__device__ __forceinline__ XcdBarrier xcd_barrier_post(unsigned* bar, volatile LAS unsigned* st) {
    XcdBarrier b; b.bar = bar; b.x = xb_xcc_id(); b.st = st;
    if (threadIdx.x == 0) (void)xb_add(&bar[XB_XCNT(b.x)], 1u);
    return b;
}
__device__ __forceinline__ void xcd_barrier_complete(unsigned* bar, unsigned x, unsigned& nloc, unsigned& nx) {
    const unsigned G = gridDim.x * gridDim.y * gridDim.z;
    unsigned sum, cnt, mine, sp = 0u;
    for (;;) {
        sum = 0u; cnt = 0u; mine = 0u;
#pragma unroll
        for (unsigned j = 0; j < 16; ++j) { const unsigned c = xb_ld(&bar[XB_XCNT(j)]); sum += c; cnt += (c > 0u) ? 1u : 0u; mine = (j == x) ? c : mine; }
        if (sum == G) break;
        __builtin_amdgcn_s_sleep(1);
        if ((++sp & 255u) == 0u) { if (xb_ld(&bar[XB_TMO])) break; if (sp > XB_SPIN_CAP) { atomicAdd(&bar[XB_TMO], 1u); break; } }
    }
    nloc = mine > 0u ? mine : 1u; nx = cnt > 0u ? cnt : 1u;
}
__device__ __forceinline__ void xcd_barrier(const XcdBarrier& b) {
    asm volatile("s_waitcnt vmcnt(0)" ::: "memory");
    __syncthreads();
    if (threadIdx.x == 0) {
        unsigned* bar = b.bar;
        __builtin_amdgcn_s_waitcnt(0);
        unsigned nloc = b.st[0], nx = b.st[1];
        if (nloc == 0u) { xcd_barrier_complete(bar, b.x, nloc, nx); b.st[0] = nloc; b.st[1] = nx; }
        const unsigned old = xb_add(&bar[XB_XSUB(b.x)], 1u);
        const unsigned gen = old / nloc;
        if (old + 1u == (gen + 1u) * nloc) {
            __builtin_amdgcn_fence(__ATOMIC_RELEASE, "agent");
            asm volatile("s_waitcnt vmcnt(0)" ::: "memory");
            const unsigned og = xb_add(&bar[XB_TOP], 1u);
            const unsigned tg = og / nx;
            if (og + 1u == (tg + 1u) * nx) xb_add(&bar[XB_TOPGEN], 1u);
            else XB_SPIN(xb_ld(&bar[XB_TOPGEN]) == tg, bar);
            __builtin_amdgcn_fence(__ATOMIC_ACQUIRE, "agent");
            xb_add(&bar[XB_XGEN(b.x)], 1u);
            asm volatile("s_waitcnt vmcnt(0)" ::: "memory");
        } else {
            XB_SPIN(xb_ld(&bar[XB_XGEN(b.x)]) == gen, bar);
            __builtin_amdgcn_fence(__ATOMIC_ACQUIRE, "agent");
            asm volatile("s_waitcnt vmcnt(0)" ::: "memory");
        }
    }
    __syncthreads();
}

__device__ __forceinline__ void tr_item(const float* W, int N, bf16_t* WT, int ldk, int k0, int n0, int drow0, const float* gk, LAS float* scr, int lane) {
    float wv[32];
#pragma unroll
    for (int i = 0; i < 32; ++i) { const int kk = 2 * i + (lane >> 5); wv[i] = W[(size_t)(k0 + kk) * N + n0 + (lane & 31)]; }
    if (gk) {
#pragma unroll
        for (int i = 0; i < 32; ++i) wv[i] *= gk[k0 + 2 * i + (lane >> 5)]; }
#pragma unroll
    for (int i = 0; i < 32; ++i) { const int kk = 2 * i + (lane >> 5); scr[kk * 33 + (lane & 31)] = wv[i]; }
    LDS_WAIT(); asm volatile("" ::: "memory");
    const int c = lane & 7;
#pragma unroll
    for (int j = 0; j < 4; ++j) { const int n = (lane >> 3) + 8 * j; const LAS float* s = scr + (8 * c) * 33 + n;
        u32x4 o; o.x = pk2(s[0 * 33], s[1 * 33]); o.y = pk2(s[2 * 33], s[3 * 33]); o.z = pk2(s[4 * 33], s[5 * 33]); o.w = pk2(s[6 * 33], s[7 * 33]);
        *(u32x4*)(WT + (size_t)(drow0 + n) * ldk + k0 + 8 * c) = o; }
    LDS_WAIT(); asm volatile("" ::: "memory");
}
__device__ __forceinline__ void tr_item8(const float* W, int N, unsigned char* WT, int ldk, int k0, int n0, int drow0, LAS float* scr, int lane) {
    float wv[32];
#pragma unroll
    for (int i = 0; i < 32; ++i) { const int kk = 2 * i + (lane >> 5); wv[i] = W[(size_t)(k0 + kk) * N + n0 + (lane & 31)]; }
#pragma unroll
    for (int i = 0; i < 32; ++i) { const int kk = 2 * i + (lane >> 5); scr[kk * 33 + (lane & 31)] = wv[i] * W8_MUL; }
    LDS_WAIT(); asm volatile("" ::: "memory");
    const int c = lane & 3;
#pragma unroll
    for (int j = 0; j < 2; ++j) { const int n = (lane >> 2) + 16 * j; const LAS float* s = scr + (16 * c) * 33 + n;
        u32x4 o; o.x = pk4_fp8(s[0 * 33], s[1 * 33], s[2 * 33], s[3 * 33]); o.y = pk4_fp8(s[4 * 33], s[5 * 33], s[6 * 33], s[7 * 33]);
        o.z = pk4_fp8(s[8 * 33], s[9 * 33], s[10 * 33], s[11 * 33]); o.w = pk4_fp8(s[12 * 33], s[13 * 33], s[14 * 33], s[15 * 33]);
        *(u32x4*)(WT + (size_t)(drow0 + n) * ldk + k0 + 16 * c) = o; }
    LDS_WAIT(); asm volatile("" ::: "memory");
}
constexpr int CI_IN = 16 * 67, CI_OUT = 16 * 32, CI_UQ = 3 * 12, CI_UKV = 2 * 16, CI_SMALL = CI_IN + CI_OUT + CI_UQ + CI_UKV, CI_E = 512, CI_MOE = 3 * 16 * CI_E;
__device__ __forceinline__ void conv_small_item(const Args& a, int l, int it, LAS float* scr, int lane) {
    unsigned char* ws = a.ws;
    if (it < CI_IN) { const int kb = it / 67, nb = it % 67; tr_item(arg_in(a, I_WIN) + (size_t)l * DM * INC, INC, (bf16_t*)(ws + WS_WIN) + (size_t)l * INCP * DM, DM, 64 * kb, 32 * nb, 32 * nb, nullptr, scr, lane); return; }
    it -= CI_IN;
    if (it < CI_OUT) { const int kb = it / 32, nb = it % 32; tr_item(arg_in(a, I_WOUT) + (size_t)l * DM * DM, DM, (bf16_t*)(ws + WS_WOUT) + (size_t)l * DM * DM, DM, 64 * kb, 32 * nb, 32 * nb, nullptr, scr, lane); return; }
    it -= CI_OUT;
    if (it < CI_UQ) { const int kb = it / 12, nb = it % 12; tr_item(arg_in(a, I_BWUQ) + (size_t)l * 192 * 384, 384, (bf16_t*)(ws + WS_WUQ) + (size_t)l * 2 * 512 * 256, 256, 64 * kb, 32 * nb, 32 * nb, arg_in(a, I_BQN) + l * 192, scr, lane); return; }
    it -= CI_UQ;
    { const int kb = it / 16, nb = it % 16; tr_item(arg_in(a, I_BWUKV) + (size_t)l * 128 * 512, 512, (bf16_t*)(ws + WS_WUQ) + ((size_t)l * 2 + 1) * 512 * 256, 256, 64 * kb, 32 * nb, 32 * nb, arg_in(a, I_BKVN) + l * 128, scr, lane); }
}
__device__ __forceinline__ void conv_moe_item(const Args& a, int l, int it, LAS float* scr, int lane) {
    unsigned char* ws = a.ws;
    const int e = it / (3 * CI_E), r = it % (3 * CI_E), which = r / CI_E, q = r % CI_E, kb = q / 32, nb = q % 32, n0 = 32 * nb;
    const size_t eo = ((size_t)l * NEXP + e) * DM * DM;
    if (which == 0)      tr_item8(arg_in(a, I_WGATE) + eo, DM, ws + WS_WGU + (size_t)l * WS_WL + (size_t)e * 2048 * DM, DM, 64 * kb, n0, (n0 >> 7) * 256 + (n0 & 127), scr, lane);
    else if (which == 1) tr_item8(arg_in(a, I_WUP) + eo, DM, ws + WS_WGU + (size_t)l * WS_WL + (size_t)e * 2048 * DM, DM, 64 * kb, n0, (n0 >> 7) * 256 + 128 + (n0 & 127), scr, lane);
    else                 tr_item8(arg_in(a, I_WDOWN) + eo, DM, ws + WS_WDN + (size_t)l * WS_WL + (size_t)e * DM * DM, DM, 64 * kb, n0, n0, scr, lane);
}
__device__ __forceinline__ void bg_convert(const Args& a, int l, int first, int n, int rank, int nranks, unsigned char* lds) {
    const TI ti = mk_ti(); LAS float* scr = (LAS float*)((LAS unsigned char*)lds + ti.wave * 16384);
    const int W = nranks * NWAVES;
    for (int it = first + rank * NWAVES + ti.wave; it < first + n; it += W) conv_moe_item(a, l, it, scr, ti.lane);
}
constexpr int BG0_A = 17000, BG0_B = 0;
constexpr int BG1_U = 4096, BG1_D = 5120, BG1_A = 8192;
__device__ __forceinline__ void mod_item(const Args& a, int item, unsigned char* lds, int tid) {
    const int l = item / 96, col0 = (item % 96) * 64;
    float* sil = (float*)lds;
    float* red = (float*)(lds + 12288);
    for (int i = tid; i < 3 * DM; i += NTHREADS) { const int r = i / DM, k = i % DM; const float v = (r < 2) ? arg_in(a, I_C)[r * DM + k] : arg_in(a, I_CCTX)[k]; sil[i] = siluf(v); }
    __syncthreads();
    const int col = tid & 63, kg = tid >> 6; const float* W = arg_in(a, I_WMOD) + (size_t)l * DM * 6144 + col0 + col;
    float a0 = 0.f, a1 = 0.f, a2 = 0.f;
#pragma unroll 64
    for (int k = kg * 128; k < kg * 128 + 128; ++k) { const float w = W[(size_t)k * 6144]; a0 += sil[k] * w; a1 += sil[DM + k] * w; a2 += sil[2 * DM + k] * w; }
    red[(kg * 3 + 0) * 64 + col] = a0; red[(kg * 3 + 1) * 64 + col] = a1; red[(kg * 3 + 2) * 64 + col] = a2;
    __syncthreads();
    if (tid < 192) { const int r = tid / 64, c = tid % 64; float s = 0.f;
#pragma unroll
        for (int g = 0; g < 8; ++g) s += red[(g * 3 + r) * 64 + c];
        ((float*)(a.ws + WS_MOD))[((size_t)l * 3 + r) * 6144 + col0 + c] = s + arg_in(a, I_BMOD)[l * 6144 + col0 + c]; }
    __syncthreads();
}

__device__ __forceinline__ void p0_prologue(const Args& a, unsigned char* lds) {
    const TI ti = mk_ti(); const int gw = ti.gw, ngw = ti.ngw, gtid = ti.gtid, ngt = ti.ngt, wave = ti.wave, lane = ti.lane;
    for (int it = blockIdx.x; it < 192; it += gridDim.x) mod_item(a, it, lds, ti.tid);
    LAS float* scr = (LAS float*)((LAS unsigned char*)lds + wave * 16384);
    for (int it = gw; it < 2 * CI_SMALL; it += ngw) {
        if (it < CI_SMALL) conv_small_item(a, 0, it, scr, lane);
        else conv_small_item(a, 1, it - CI_SMALL, scr, lane);
    }
    { unsigned zz_ = 0u; asm volatile("" : "+v"(zz_)); const u32x4 z = {zz_, zz_, zz_, zz_};
      constexpr int ZIN = 160 * 128, ZUQ1 = 384 * 8, ZUQ2 = 128 * 32, ZUKV = 512 * 16, ZL = ZIN + ZUQ1 + ZUQ2 + ZUKV;
      for (int i = gtid; i < 2 * ZL; i += ngt) { const int l = i / ZL; int q = i % ZL;
          if (q < ZIN) { *(u32x4*)((bf16_t*)(a.ws + WS_WIN) + ((size_t)l * INCP + INC) * DM + (size_t)q * 8) = z; continue; } q -= ZIN;
          bf16_t* uq = (bf16_t*)(a.ws + WS_WUQ) + (size_t)l * 2 * 512 * 256;
          if (q < ZUQ1) { *(u32x4*)(uq + (size_t)(q >> 3) * 256 + 192 + (q & 7) * 8) = z; continue; } q -= ZUQ1;
          if (q < ZUQ2) { *(u32x4*)(uq + (size_t)384 * 256 + (size_t)q * 8) = z; continue; } q -= ZUQ2;
          *(u32x4*)(uq + (size_t)512 * 256 + (size_t)(q >> 4) * 256 + 128 + (q & 15) * 8) = z; } }
    for (int i = gtid; i < 128 * 16 + 128 * 8; i += ngt) {
        if (i < 2048) { const int pos = i >> 4, k = i & 15; const float f = exp2f(-(float)k * (13.287712379549449f / 16.f)); const float ang = (float)pos * f; float* t = (float*)(a.ws + WS_TAB64) + 2 * i; t[0] = cosf(ang); t[1] = sinf(ang); }
        else { const int q = i - 2048, pos = q >> 3, k = q & 7; const float f = exp2f(-(float)k * (13.287712379549449f / 8.f)); const float ang = (float)pos * f; float* t = (float*)(a.ws + WS_TAB32) + 2 * q; t[0] = cosf(ang); t[1] = sinf(ang); }
    }
    if (gtid < DEPTH) { const float* lp = arg_in(a, I_CLAM) + gtid * 128; float s1 = 0.f, s2 = 0.f;
        for (int i = 0; i < 32; ++i) { s1 += lp[i] * lp[32 + i]; s2 += lp[64 + i] * lp[96 + i]; }
        const float lam_init = 0.8f - 0.6f * expf(-0.3f * (float)gtid);
        ((float*)(a.ws + WS_LAM))[gtid] = expf(s1) - expf(s2) + lam_init; }
}

__device__ __forceinline__ int mod_row(int b, int t) { return t < CTXL ? 2 : b; }
__device__ __forceinline__ void modulate_row(const f32x4 (&v)[4], const float* g, const float* sh, const float* sc, bf16_t* hrow, int lane, f32x4 (*hout)[4] = nullptr) {
    float ss = 0.f;
#pragma unroll
    for (int j = 0; j < 4; ++j) ss += (v[j].x * v[j].x + v[j].y * v[j].y) + (v[j].z * v[j].z + v[j].w * v[j].w);
    const float rstd = rsqrtf(wave_sum(ss, lane) * (1.f / DM) + EPS);
#pragma unroll
    for (int j = 0; j < 4; ++j) { const int c = 4 * lane + 256 * j;
        const f32x4 gg = *(const f32x4*)(g + c), s1 = *(const f32x4*)(sc + c), s0 = *(const f32x4*)(sh + c);
        const f32x4 h = (v[j] * rstd) * gg * (s1 + 1.f) + s0;
        if (hout) (*hout)[j] = h;
        u32x2 w; w.x = pk2(h.x, h.y); w.y = pk2(h.z, h.w); *(u32x2*)(hrow + c) = w; }
}

struct ModVec { f32x4 g[4], s1[4], s0[4]; };
__device__ __forceinline__ void load_modvec(ModVec& mv, const float* g, const float* sh, const float* sc, int lane) {
#pragma unroll
    for (int j = 0; j < 4; ++j) { const int c = 4 * lane + 256 * j; mv.g[j] = *(const f32x4*)(g + c); mv.s1[j] = *(const f32x4*)(sc + c) + 1.f; mv.s0[j] = *(const f32x4*)(sh + c); }
}
template <bool FP8 = false>
__device__ __forceinline__ void modulate_row_c(const f32x4 (&v)[4], const ModVec& mv, bf16_t* hrow, int lane, f32x4 (*hout)[4] = nullptr) {
    float ss = 0.f;
#pragma unroll
    for (int j = 0; j < 4; ++j) ss += (v[j].x * v[j].x + v[j].y * v[j].y) + (v[j].z * v[j].z + v[j].w * v[j].w);
    const float rstd = rsqrtf(wave_sum(ss, lane) * (1.f / DM) + EPS);
#pragma unroll
    for (int j = 0; j < 4; ++j) { const int c = 4 * lane + 256 * j;
        const f32x4 h = (v[j] * rstd) * mv.g[j] * mv.s1[j] + mv.s0[j];
        if (hout) (*hout)[j] = h;
        if constexpr (FP8) *(unsigned*)((unsigned char*)hrow + c) = pk4_fp8(h.x, h.y, h.z, h.w);
        else { u32x2 w; w.x = pk2(h.x, h.y); w.y = pk2(h.z, h.w); *(u32x2*)(hrow + c) = w; } }
}

__device__ __forceinline__ void p1_norm1_l0(const Args& a) {
    const TI ti = mk_ti(); const int gw = ti.gw, ngw = ti.ngw, lane = ti.lane;
    bf16_t* X = (bf16_t*)(a.ws + WS_X); bf16_t* H = (bf16_t*)(a.ws + WS_H); const float* MOD = (const float*)(a.ws + WS_MOD);
    ModVec mv; int curmr = -1;
    for (int r0 = gw; r0 < NR; r0 += 2 * ngw) { f32x4 v[2][4];
#pragma unroll
        for (int q = 0; q < 2; ++q) { const int r = (r0 + q * ngw < NR) ? r0 + q * ngw : r0; const int b = r / RB, t = r % RB;
            const float* src = (t < CTXL) ? arg_in(a, I_CTX) + ((size_t)b * CTXL + t) * DM : arg_in(a, I_X) + ((size_t)b * SEQ + (t - CTXL)) * DM;
#pragma unroll
            for (int j = 0; j < 4; ++j) v[q][j] = *(const f32x4*)(src + 4 * lane + 256 * j); }
#pragma unroll
        for (int q = 0; q < 2; ++q) { const int r = r0 + q * ngw; if (r < NR) { const int b = r / RB, t = r % RB;
#pragma unroll
            for (int j = 0; j < 4; ++j) stx4(X + (size_t)r * DM + 4 * lane + 256 * j, v[q][j]);
            { const int mr = mod_row(b, t); if (mr != curmr) { curmr = mr; const float* m = MOD + (size_t)mr * 6144; load_modvec(mv, arg_in(a, I_GATTN), m, m + 1024, lane); } }
            modulate_row_c(v[q], mv, H + (size_t)r * DM, lane); } } }
}

__device__ __forceinline__ void rope_pair(float& x1, float& x2, const float* tab) { const float c = tab[0], s = tab[1]; const float y1 = x1 * c - x2 * s, y2 = x1 * s + x2 * c; x1 = y1; x2 = y2; }

struct P3Raw { u32x4 a1, a2, c1, c2, q8, kv8; f32x4 t64[4], t32[4]; };
__device__ __forceinline__ void p3_load(const Args& a, int r, const bf16_t* pr, int lane, P3Raw& w) {
    { const float* T64 = (const float*)(a.ws + WS_TAB64); const float* T32 = (const float*)(a.ws + WS_TAB32);
      const int t = r % RB; const int p = t >= CTXL ? t - CTXL : 0, py = p >> 6, px = p & 63;
      const int part4 = lane & 3, part2 = lane & 1;
      const float* tab64 = T64 + ((part4 < 2 ? py : px) * 16 + 8 * (part4 & 1)) * 2; const float* tab32 = T32 + ((part2 == 0 ? py : px) * 8) * 2;
#pragma unroll
      for (int k = 0; k < 4; ++k) { w.t64[k] = *(const f32x4*)(tab64 + 4 * k); w.t32[k] = *(const f32x4*)(tab32 + 4 * k); } }
    { const int hd = lane >> 2, part = lane & 3; const int hh = hd < 12 ? hd : 0;
      const int sc_ = hh < 4 ? PA_Q + 64 * hh : hh < 6 ? PA_K + 64 * (hh - 4) : hh < 10 ? PD_Q + 64 * (hh - 6) : PD_K + 64 * (hh - 10);
      w.a1 = *(const u32x4*)(pr + sc_ + 8 * part); w.a2 = *(const u32x4*)(pr + sc_ + 32 + 8 * part); }
    { const int gr = lane >> 1, part = lane & 1; const int gg = gr < 17 ? gr : 0;
      const int sc_ = gg < 8 ? PC_Q + 32 * gg : gg < 16 ? PC_K + 32 * (gg - 8) : PB_KR;
      w.c1 = *(const u32x4*)(pr + sc_ + 8 * part); w.c2 = *(const u32x4*)(pr + sc_ + 16 + 8 * part); }
    w.q8 = *(const u32x4*)(pr + PB_CQ + 8 * (lane < 24 ? lane : 0));
    w.kv8 = *(const u32x4*)(pr + PB_CKV + 8 * (lane < 16 ? lane : 0));
}
__device__ __forceinline__ float sq8(const u32x4& v) { float s = 0.f;
#pragma unroll
    for (int k = 0; k < 4; ++k) { const float lo = bflo(v[k]), hi = bfhi(v[k]); s += lo * lo + hi * hi; } return s; }
struct P3Gain { float g1[8], g2[8]; };
template <bool USEG>
__device__ __forceinline__ void rot8(const u32x4& x1, const u32x4& x2, const f32x4 (&t)[4], bool rot, float s1, const P3Gain& g, float scale, u32x4& y1, u32x4& y2) {
    float a[8], b[8];
#pragma unroll
    for (int k = 0; k < 4; ++k) { a[2 * k] = bflo(x1[k]); a[2 * k + 1] = bfhi(x1[k]); b[2 * k] = bflo(x2[k]); b[2 * k + 1] = bfhi(x2[k]); }
    if constexpr (USEG) {
#pragma unroll
        for (int k = 0; k < 8; ++k) { a[k] *= s1 * g.g1[k]; b[k] *= s1 * g.g2[k]; } }
    if (rot) {
#pragma unroll
        for (int k = 0; k < 8; ++k) { const float c = t[k >> 1][(k & 1) * 2], s = t[k >> 1][(k & 1) * 2 + 1]; const float y = a[k] * c - b[k] * s, z = a[k] * s + b[k] * c; a[k] = y; b[k] = z; } }
#pragma unroll
    for (int k = 0; k < 4; ++k) { y1[k] = pk2(a[2 * k] * scale, a[2 * k + 1] * scale); y2[k] = pk2(b[2 * k] * scale, b[2 * k + 1] * scale); }
}
__device__ __forceinline__ void p3_compute(const Args& a, int l, int r, int lane, const P3Raw& w, const P3Gain& gg) {
    bf16_t* AT = (bf16_t*)(a.ws + WS_ATT);
    const float* T64 = (const float*)(a.ws + WS_TAB64); const float* T32 = (const float*)(a.ws + WS_TAB32); float* RS = (float*)(a.ws + WS_RS);
    const float C64 = 0.125f * LOG2E, C32 = 0.17677669529663687f * LOG2E;
    const int t = r % RB; const bool lat = t >= CTXL; const int p = t - CTXL, py = p >> 6, px = p & 63;
    { const int hd = lane >> 2, part = lane & 3;
      float ss = sq8(w.a1) + sq8(w.a2); ss += shx(ss, 1, lane); ss += shx(ss, 2, lane);
      if (hd < 12) {
          bf16_t* dst; float scale = 1.f;
          if (hd < 4) { dst = AT + AO_QA + (size_t)r * 256 + 64 * hd; scale = C64; }
          else if (hd < 6) { dst = AT + AO_KA + (size_t)r * 128 + 64 * (hd - 4); }
          else if (hd < 10) { dst = AT + AO_QD + (size_t)r * 256 + 64 * (hd - 6); scale = C64; }
          else { dst = AT + AO_KD + (size_t)r * 128 + 64 * (hd - 10); }
          const float rs = hd >= 6 ? rsqrtf(ss * (1.f / 64.f) + EPS) : 1.f;
          u32x4 y1, y2; rot8<true>(w.a1, w.a2, w.t64, lat, rs, gg, scale, y1, y2);
          *(u32x4*)(dst + 8 * part) = y1; *(u32x4*)(dst + 32 + 8 * part) = y2; } }
    { const int gr = lane >> 1, part = lane & 1;
      if (gr < 17) {
          u32x4 y1, y2; rot8<false>(w.c1, w.c2, w.t32, lat, 1.f, gg, gr < 8 ? C32 : 1.f, y1, y2);
          if (gr < 16) { bf16_t* dst = AT + (gr < 8 ? AO_QC : AO_KC) + (size_t)r * 256 + 32 * (gr & 7); *(u32x4*)(dst + 8 * part) = y1; *(u32x4*)(dst + 16 + 8 * part) = y2; }
          else { bf16_t* kb = AT + AO_KB + (size_t)r * 384 + 64;
#pragma unroll
              for (int h = 0; h < 4; ++h) { *(u32x4*)(kb + h * 96 + 8 * part) = y1; *(u32x4*)(kb + h * 96 + 16 + 8 * part) = y2; } } } }
    { float s1 = lane < 24 ? sq8(w.q8) : 0.f, s2 = lane < 16 ? sq8(w.kv8) : 0.f;
      s1 = wave_sum(s1, lane); s2 = wave_sum(s2, lane);
      if (lane == 0) { RS[2 * r] = rsqrtf(s1 * (1.f / 192.f) + EPS); RS[2 * r + 1] = rsqrtf(s2 * (1.f / 128.f) + EPS); } }
}
__device__ __forceinline__ void p3_rows(const Args& a, int l, int brank, int nbranks) {
    const TI ti = mk_ti(); const int gw = brank * NWAVES + ti.wave, ngw = nbranks * NWAVES, lane = ti.lane;
    const bf16_t* PROJ = (const bf16_t*)(a.ws + WS_PROJ);
    P3Gain gg;
    { const int hd = lane >> 2, part = lane & 3; const float* gn = (hd >= 6 && hd < 10) ? arg_in(a, I_DQN) + l * 64 : (hd >= 10 && hd < 12) ? arg_in(a, I_DKN) + l * 64 : nullptr;
#pragma unroll
      for (int k = 0; k < 8; ++k) { gg.g1[k] = gn ? gn[8 * part + k] : 1.f; gg.g2[k] = gn ? gn[32 + 8 * part + k] : 1.f; } }
    for (int r = gw; r < NR; r += 2 * ngw) { const int r2 = r + ngw; const bool two = r2 < NR;
        P3Raw wa, wb; p3_load(a, r, PROJ + (size_t)r * INCP, lane, wa); p3_load(a, two ? r2 : r, PROJ + (size_t)(two ? r2 : r) * INCP, lane, wb);
        p3_compute(a, l, r, lane, wa, gg); if (two) p3_compute(a, l, r2, lane, wb, gg); }
}

__device__ __forceinline__ void p3c_rows(const Args& a) {
    const TI ti = mk_ti(); const int gw = ti.gw, ngw = ti.ngw, lane = ti.lane;
    bf16_t* AT = (bf16_t*)(a.ws + WS_ATT); const float* T32 = (const float*)(a.ws + WS_TAB32); const float* RS = (const float*)(a.ws + WS_RS);
    const float CB = 0.10206207261596575f * LOG2E;
    const int h = lane >> 4, i = lane & 15;
    for (int r0 = gw; r0 < NR; r0 += 2 * ngw) {
        u32x2 wq[2]; unsigned short x1r[2], x2r[2]; u32x4 wk[2]; float rsq[2], rsk[2];
#pragma unroll
        for (int q = 0; q < 2; ++q) { const int r = (r0 + q * ngw < NR) ? r0 + q * ngw : r0;
            const bf16_t* qbr = AT + AO_QBR + (size_t)r * 512; const bf16_t* kvr = AT + AO_KVBR + (size_t)r * 512;
            wq[q] = *(const u32x2*)(qbr + h * 96 + 4 * i); x1r[q] = qbr[h * 96 + 64 + i]; x2r[q] = qbr[h * 96 + 80 + i]; wk[q] = *(const u32x4*)(kvr + 8 * lane); rsq[q] = RS[2 * r]; rsk[q] = RS[2 * r + 1]; }
#pragma unroll
        for (int q = 0; q < 2; ++q) { const int r = r0 + q * ngw; if (r < NR) {
            const int t = r % RB; const bool lat = t >= CTXL; const int pp = t - CTXL, py = pp >> 6, px = pp & 63;
            const float rq = rsq[q] * CB, rkv = rsk[q];
            bf16_t* qb = AT + AO_QB + (size_t)r * 384; bf16_t* kb = AT + AO_KB + (size_t)r * 384; bf16_t* vb = AT + AO_VB + (size_t)r * 256;
            { const u32x2 w = wq[q]; u32x2 o; o.x = pk2(bflo(w.x) * rq, bfhi(w.x) * rq); o.y = pk2(bflo(w.y) * rq, bfhi(w.y) * rq); *(u32x2*)(qb + h * 96 + 4 * i) = o; }
            { float x1 = bf2f(x1r[q]), x2 = bf2f(x2r[q]);
              if (lat) rope_pair(x1, x2, T32 + ((i < 8 ? py : px) * 8 + (i & 7)) * 2);
              qb[h * 96 + 64 + i] = (bf16_t)f2bf(x1 * rq); qb[h * 96 + 80 + i] = (bf16_t)f2bf(x2 * rq); }
            { const u32x4 w = wk[q]; u32x4 o;
              o.x = pk2(bflo(w.x) * rkv, bfhi(w.x) * rkv); o.y = pk2(bflo(w.y) * rkv, bfhi(w.y) * rkv); o.z = pk2(bflo(w.z) * rkv, bfhi(w.z) * rkv); o.w = pk2(bflo(w.w) * rkv, bfhi(w.w) * rkv);
              const int within = (8 * lane) & 127;
              if (within < 64) *(u32x4*)(kb + h * 96 + within) = o; else *(u32x4*)(vb + h * 64 + within - 64) = o; } } }
    }
}

__device__ __forceinline__ void p6_norm2_router(const Args& a, int l, bool last, int rows, int brank, int nbranks, unsigned char* lds) {
    const TI ti = mk_ti(); const int gw = brank * NWAVES + ti.wave, ngw = nbranks * NWAVES, lane = ti.lane;
    const int NI = rows == 0 ? NR : rows == 1 ? NBATCH * SEQ : NBATCH * CTXL;
#define P6_ROW(idx) (rows == 0 ? (idx) : rows == 1 ? (idx) + CTXL + ((idx) >= SEQ ? CTXL : 0) : (idx) + ((idx) >= CTXL ? SEQ : 0))
    float* wr = (float*)lds;
    { const float* W = arg_in(a, I_WROUTER) + (size_t)l * DM * NEXP;
      f32x4 wv[8];
#pragma unroll
      for (int k = 0; k < 8; ++k) { const int i = ti.tid + k * NTHREADS; const int c = i >> 2, q = i & 3; wv[k] = *(const f32x4*)(W + c * 16 + q * 4); }
#pragma unroll
      for (int k = 0; k < 8; ++k) { const int i = ti.tid + k * NTHREADS; const int c = i >> 2, q = i & 3; const int rho = ((c >> 8) * 4 + (c & 3)) * 64 + ((c >> 2) & 63);
          *(f32x4*)(wr + ((size_t)q * DM + rho) * 4) = wv[k]; } }
    static_assert(DM * 4 == 8 * NTHREADS, "router weight staging");
    __syncthreads();
    const bf16_t* X = (const bf16_t*)(a.ws + WS_X); bf16_t* H = (bf16_t*)(a.ws + WS_H); const float* MOD = (const float*)(a.ws + WS_MOD) + (size_t)l * 3 * 6144; float* AFF = (float*)(a.ws + WS_AFF);
    f32x4 vn[4];
#pragma unroll
    for (int j = 0; j < 4; ++j) vn[j] = ldx4(X + (size_t)P6_ROW(gw < NI ? gw : 0) * DM + 4 * lane + 256 * j);
    ModVec mv; int curmr = -1;
    const int myexp = ((lane >> 5) & 1) * 8 + ((lane >> 4) & 1) * 4 + ((lane >> 3) & 1) * 2 + ((lane >> 2) & 1);
    for (int idx = gw; idx < NI; idx += ngw) { const int r = P6_ROW(idx); const int b = r / RB, t = r % RB;
        f32x4 v[4], h[4];
#pragma unroll
        for (int j = 0; j < 4; ++j) v[j] = vn[j];
        { const int rn = P6_ROW((idx + ngw < NI) ? idx + ngw : idx);
#pragma unroll
          for (int j = 0; j < 4; ++j) vn[j] = ldx4(X + (size_t)rn * DM + 4 * lane + 256 * j); }
        if (last && t < CTXL) continue;
        { const int mr = mod_row(b, t); if (mr != curmr) { const float* m = MOD + (size_t)mr * 6144; load_modvec(mv, arg_in(a, I_GFFN) + l * DM, m + 3072, m + 4096, lane); curmr = mr; } }
        modulate_row_c<true>(v, mv, (bf16_t*)((unsigned char*)H + (size_t)r * DM), lane, &h);
        float lg[16];
#pragma unroll
        for (int e = 0; e < 16; ++e) lg[e] = 0.f;
#pragma unroll
        for (int j = 0; j < 4; ++j) {
            f32x4 ww[4][4];
#pragma unroll
            for (int i = 0; i < 4; ++i)
#pragma unroll
                for (int q = 0; q < 4; ++q) ww[i][q] = *(const f32x4*)(wr + ((size_t)q * DM + (j * 4 + i) * 64 + lane) * 4);
#pragma unroll
            for (int i = 0; i < 4; ++i) { const float hv = h[j][i];
#pragma unroll
                for (int q = 0; q < 4; ++q) { lg[4 * q] += hv * ww[i][q].x; lg[4 * q + 1] += hv * ww[i][q].y; lg[4 * q + 2] += hv * ww[i][q].z; lg[4 * q + 3] += hv * ww[i][q].w; } }
        }
        float v8[8], v4[4], v2[2], v1;
#pragma unroll
        for (int k = 0; k < 8; ++k) { const bool up = lane & 32; const float mine = up ? lg[k + 8] : lg[k], oth = up ? lg[k] : lg[k + 8]; v8[k] = mine + shx(oth, 32, lane); }
#pragma unroll
        for (int k = 0; k < 4; ++k) { const bool up = lane & 16; const float mine = up ? v8[k + 4] : v8[k], oth = up ? v8[k] : v8[k + 4]; v4[k] = mine + shx(oth, 16, lane); }
#pragma unroll
        for (int k = 0; k < 2; ++k) { const bool up = lane & 8; const float mine = up ? v4[k + 2] : v4[k], oth = up ? v4[k] : v4[k + 2]; v2[k] = mine + shx(oth, 8, lane); }
        { const bool up = lane & 4; const float mine = up ? v2[1] : v2[0], oth = up ? v2[0] : v2[1]; v1 = mine + shx(oth, 4, lane); }
        v1 += shx(v1, 1, lane); v1 += shx(v1, 2, lane);
        float mx = v1;
#pragma unroll
        for (int o = 4; o < 64; o <<= 1) mx = fmaxf(mx, shx(mx, o, lane));
        const float pe = __expf(v1 - mx); float den = pe;
#pragma unroll
        for (int o = 4; o < 64; o <<= 1) den += shx(den, o, lane);
        if ((lane & 3) == 0) AFF[((size_t)b * NEXP + myexp) * RB + t] = pe / den;
    }
#undef P6_ROW
    asm volatile("s_waitcnt vmcnt(0)" ::: "memory");
    __syncthreads();
}

__device__ __forceinline__ void p7_topk(const Args& a, int q, unsigned char* lds) {
    const TI ti = mk_ti(); const int tid = ti.tid, lane = ti.lane, wave = ti.wave;
    int* hist = (int*)lds;
    int* selv = (int*)(lds + 1024);
    int* wsum = (int*)(lds + 1024 + 64);
    const bool isctx = q >= 32; const int g = isctx ? q - 32 : q, b = g >> 4, e = g & 15;
    const int n = isctx ? CTXL : SEQ, k = isctx ? CAPC : CAPL;
    const float* src = (const float*)(a.ws + WS_AFF) + (size_t)g * RB + (isctx ? 0 : CTXL);
    const int yrow0 = isctx ? (128 + e) * 256 + b * CAPC : g * CAPL, tok0 = b * RB + (isctx ? 0 : CTXL);
    unsigned key[16];
#pragma unroll
    for (int j4 = 0; j4 < 4; ++j4) { const int i0 = tid * 16 + j4 * 4; u32x4 kv = {0u, 0u, 0u, 0u}; if (i0 < n) kv = *(const u32x4*)(src + i0); key[j4 * 4] = kv.x; key[j4 * 4 + 1] = kv.y; key[j4 * 4 + 2] = kv.z; key[j4 * 4 + 3] = kv.w; }
    unsigned prefix = 0u, mask = 0u; int kk = k;
    for (int pass = 0; pass < 4; ++pass) { const int shift = 24 - 8 * pass;
        if (tid < 256) hist[tid] = 0;
        __syncthreads();
#pragma unroll
        for (int j = 0; j < 16; ++j) if ((key[j] & mask) == prefix) atomicAdd(&hist[(key[j] >> shift) & 255u], 1);
        __syncthreads();
        if (wave == 0) {
            const int h0 = hist[4 * lane], h1 = hist[4 * lane + 1], h2 = hist[4 * lane + 2], h3 = hist[4 * lane + 3];
            const int s = h0 + h1 + h2 + h3; int incl = s;
#pragma unroll
            for (int o = 1; o < 64; o <<= 1) { const int v = shidx(incl, (lane + o) & 63); if (lane + o < 64) incl += v; }
            int cum = incl - s;
            if (cum < kk && cum + s >= kk) {
                int d = 4 * lane + 3;
                if (cum + h3 >= kk) { d = 4 * lane + 3; } else { cum += h3; if (cum + h2 >= kk) d = 4 * lane + 2; else { cum += h2; if (cum + h1 >= kk) d = 4 * lane + 1; else { cum += h1; d = 4 * lane; } } }
                selv[0] = d; selv[1] = kk - cum; }
        }
        __syncthreads();
        prefix |= (unsigned)selv[0] << shift; mask |= 255u << shift; kk = selv[1];
        __syncthreads();
    }
    int cgt = 0, ceq = 0;
#pragma unroll
    for (int j = 0; j < 16; ++j) { cgt += key[j] > prefix ? 1 : 0; ceq += key[j] == prefix ? 1 : 0; }
    int pk = cgt | (ceq << 16), incl = pk;
#pragma unroll
    for (int o = 1; o < 64; o <<= 1) { const int v = shidx(incl, (lane - o) & 63); if (lane >= o) incl += v; }
    if (lane == 63) wsum[wave] = incl;
    __syncthreads();
    int base = 0, total = 0;
#pragma unroll
    for (int w = 0; w < 8; ++w) { const int v = wsum[w]; if (w < wave) base += v; total += v; }
    int excl = base + incl - pk; int rgt = excl & 0xffff, req = excl >> 16; const int tgt = total & 0xffff;
    int* IDX = (int*)(a.ws + WS_IDX); float* GATEY = (float*)(a.ws + WS_GATEY); int* SLOT = (int*)(a.ws + WS_SLOT);
#pragma unroll
    for (int j = 0; j < 16; ++j) { const int i = tid * 16 + j; if (i < n) { int slot = -1;
        if (key[j] > prefix) slot = rgt++; else if (key[j] == prefix) { if (req < kk) slot = tgt + req; ++req; }
        const int row = tok0 + i;
        if (slot >= 0) { IDX[yrow0 + slot] = row; GATEY[yrow0 + slot] = __uint_as_float(key[j]); SLOT[(size_t)row * 16 + e] = yrow0 + slot; } else SLOT[(size_t)row * 16 + e] = -1; } }
    if (isctx && b == 0) { for (int i = tid; i < 192; i += NTHREADS) IDX[(128 + e) * 256 + 64 + i] = 0; }
    __syncthreads();
}

__device__ __forceinline__ void p10_combine(const Args& a, int l, bool last, float dbg, float dbgmul) {
    constexpr int NH = 2;
    const TI ti = mk_ti(); const int gw = ti.gw, ngw = ti.ngw, lane = ti.lane;
    bf16_t* X = (bf16_t*)(a.ws + WS_X); bf16_t* H = (bf16_t*)(a.ws + WS_H); const float* MOD = (const float*)(a.ws + WS_MOD);
    const bf16_t* Y = (const bf16_t*)(a.ws + WS_ATT); const float* GATEY = (const float*)(a.ws + WS_GATEY); const int* SLOT = (const int*)(a.ws + WS_SLOT);
    ModVec mv; f32x4 gtv[4]; int curmr = -1;
    for (int r0 = gw; r0 < NR; r0 += 2 * ngw) {
        f32x4 v[2][4]; int myslot[2]; unsigned msk[2]; int s2[2][NH]; float g2[2][NH]; u32x2 y2[2][NH][4];
#pragma unroll
        for (int q = 0; q < 2; ++q) { const int r = (r0 + q * ngw < NR) ? r0 + q * ngw : r0; myslot[q] = SLOT[(size_t)r * 16 + (lane & 15)];
#pragma unroll
            for (int j = 0; j < 4; ++j) v[q][j] = ldx4(X + (size_t)r * DM + 4 * lane + 256 * j); }
#pragma unroll
        for (int q = 0; q < 2; ++q) { msk[q] = (unsigned)(__ballot(myslot[q] >= 0) & 0xffffull);
#pragma unroll
            for (int k = 0; k < NH; ++k) { const bool has = msk[q] != 0u; const int e = has ? __builtin_ctz(msk[q]) : 0; const int s = shidx(myslot[q], e); s2[q][k] = has ? s : 0; if (has) msk[q] &= msk[q] - 1u; g2[q][k] = has ? 1.f : 0.f; } }
#pragma unroll
        for (int q = 0; q < 2; ++q)
#pragma unroll
            for (int k = 0; k < NH; ++k) { g2[q][k] *= GATEY[s2[q][k]]; const bf16_t* yr = Y + (size_t)s2[q][k] * DM;
#pragma unroll
                for (int j = 0; j < 4; ++j) y2[q][k][j] = *(const u32x2*)(yr + 4 * lane + 256 * j); }
#pragma unroll
        for (int q = 0; q < 2; ++q) { const int r = r0 + q * ngw; if (r >= NR) continue; const int b = r / RB, t = r % RB; if (last && t < CTXL) continue;
            f32x4 acc[4];
#pragma unroll
            for (int j = 0; j < 4; ++j) { acc[j] = (f32x4){0.f, 0.f, 0.f, 0.f};
#pragma unroll
                for (int k = 0; k < NH; ++k) { const u32x2 w = y2[q][k][j]; acc[j] += (f32x4){bflo(w.x), bfhi(w.x), bflo(w.y), bfhi(w.y)} * g2[q][k]; } }
            unsigned m = msk[q];
            while (m) { const int e = __builtin_ctz(m); m &= m - 1u; const int s = shidx(myslot[q], e); const float g = GATEY[s]; const bf16_t* yr = Y + (size_t)s * DM;
#pragma unroll
                for (int j = 0; j < 4; ++j) { const u32x2 w = *(const u32x2*)(yr + 4 * lane + 256 * j); acc[j] += (f32x4){bflo(w.x), bfhi(w.x), bflo(w.y), bfhi(w.y)} * g; } }
            { const int mr = mod_row(b, t); if (mr != curmr) { curmr = mr; const float* gt = MOD + ((size_t)l * 3 + mr) * 6144 + 5120;
#pragma unroll
                for (int j = 0; j < 4; ++j) gtv[j] = *(const f32x4*)(gt + 4 * lane + 256 * j);
                if (!last) { const float* mm = MOD + ((size_t)(l + 1) * 3 + mr) * 6144; load_modvec(mv, arg_in(a, I_GATTN) + (l + 1) * DM, mm, mm + 1024, lane); } } }
#pragma unroll
            for (int j = 0; j < 4; ++j) v[q][j] += gtv[j] * acc[j] * dbg;
            if (!last) {
#pragma unroll
                for (int j = 0; j < 4; ++j) stx4(X + (size_t)r * DM + 4 * lane + 256 * j, v[q][j]);
                modulate_row_c(v[q], mv, H + (size_t)r * DM, lane);
            } else {
                float ss = 0.f;
#pragma unroll
                for (int j = 0; j < 4; ++j) ss += (v[q][j].x * v[q][j].x + v[q][j].y * v[q][j].y) + (v[q][j].z * v[q][j].z + v[q][j].w * v[q][j].w);
                const float rstd = rsqrtf(wave_sum(ss, lane) * (1.f / DM) + EPS);
                float* o = a.out + ((size_t)b * SEQ + (t - CTXL)) * DM;
#pragma unroll
                for (int j = 0; j < 4; ++j) if (dbg != 0.f) *(f32x4*)(o + 4 * lane + 256 * j) = v[q][j] * (rstd * dbgmul) * *(const f32x4*)(arg_in(a, I_GFINAL) + 4 * lane + 256 * j);
            }
        }
    }
}
#if DBGCHK
constexpr size_t WS_DBG = 32 * 1024;
__device__ __forceinline__ void dbg_fail(const Args& a, int id) { atomicAdd((int*)(a.ws + WS_DBG) + id, 1); }
__device__ __forceinline__ bool dbg_bad(float got, float ref) { return !(fabsf(got - ref) <= 0.03f + 0.03f * fabsf(ref)); }
__device__ __forceinline__ bool dbg_bad8(float got, float ref) { return !(fabsf(got - ref) <= 0.25f + 0.12f * fabsf(ref)); }
__device__ __forceinline__ float dbg_fp8(unsigned char v) { return __builtin_amdgcn_cvt_f32_fp8((int)v, 0); }
__device__ __forceinline__ unsigned dbg_hash(unsigned x) { x ^= x >> 16; x *= 0x7feb352du; x ^= x >> 15; x *= 0x846ca68bu; x ^= x >> 16; return x; }

__device__ __forceinline__ void dbg_chk_inproj(const Args& a, int l, int id) {
    const TI ti = mk_ti(); const int r = dbg_hash(ti.gw * 7919u + 13u) % NR, c = (dbg_hash(ti.gw) % (INC - 64)) + ti.lane;
    const bf16_t* h = (const bf16_t*)(a.ws + WS_H) + (size_t)r * DM; const float* W = arg_in(a, I_WIN) + (size_t)l * DM * INC + c;
    float s = 0.f; for (int k = 0; k < DM; ++k) s += bf2f(h[k]) * W[(size_t)k * INC];
    const float got = bf2f(((const bf16_t*)(a.ws + WS_PROJ))[(size_t)r * INCP + c]);
    if (dbg_bad(got, s)) dbg_fail(a, id);
}
__device__ __forceinline__ void dbg_chk_bup(const Args& a, int l, int id) {
    const TI ti = mk_ti(); const int r = dbg_hash(ti.gw * 7919u + 17u) % NR; const bf16_t* pr = (const bf16_t*)(a.ws + WS_PROJ) + (size_t)r * INCP; const bf16_t* AT = (const bf16_t*)(a.ws + WS_ATT);
    { const int c = (dbg_hash(ti.gw) % (384 - 64)) + ti.lane; float s = 0.f;
      for (int k = 0; k < 192; ++k) s += bf2f(pr[PB_CQ + k]) * arg_in(a, I_BQN)[l * 192 + k] * arg_in(a, I_BWUQ)[(size_t)l * 192 * 384 + (size_t)k * 384 + c];
      if (dbg_bad(bf2f(AT[AO_QBR + (size_t)r * 512 + c]), s)) dbg_fail(a, id); }
    { const int c = (dbg_hash(ti.gw + 5u) % (512 - 64)) + ti.lane; float s = 0.f;
      for (int k = 0; k < 128; ++k) s += bf2f(pr[PB_CKV + k]) * arg_in(a, I_BKVN)[l * 128 + k] * arg_in(a, I_BWUKV)[(size_t)l * 128 * 512 + (size_t)k * 512 + c];
      if (dbg_bad(bf2f(AT[AO_KVBR + (size_t)r * 512 + c]), s)) dbg_fail(a, id + 1); }
}
__device__ __forceinline__ void dbg_chk_moe(const Args& a, int l, bool last, int id) {
    const TI ti = mk_ti(); const int ny = last ? 128 * 256 : YROWS;
    int yr = dbg_hash(ti.gw * 31u + 3u) % ny; if (yr >= 128 * 256 && (yr & 255) >= 64) yr &= ~192;
    const int pm = yr >> 8, e = pm < 128 ? (pm >> 2) & 15 : pm - 128; const int c = (dbg_hash(ti.gw + 77u) % (DM - 64)) + ti.lane;
    const int row = ((const int*)(a.ws + WS_IDX))[yr]; const unsigned char* h = (const unsigned char*)(a.ws + WS_H) + (size_t)row * DM;
    const size_t eo = ((size_t)l * NEXP + e) * DM * DM;
    { float g = 0.f, u = 0.f; for (int k = 0; k < DM; ++k) { const float hv = dbg_fp8(h[k]); g += hv * arg_in(a, I_WGATE)[eo + (size_t)k * DM + c]; u += hv * arg_in(a, I_WUP)[eo + (size_t)k * DM + c]; }
      const float ref = g / (1.f + __expf(-g)) * u; if (dbg_bad8(dbg_fp8(((const unsigned char*)(a.ws + WS_PROJ))[(size_t)yr * DM + c]), ref)) dbg_fail(a, id); }
    { const unsigned char* act = (const unsigned char*)(a.ws + WS_PROJ) + (size_t)yr * DM; float s = 0.f; for (int k = 0; k < DM; ++k) s += dbg_fp8(act[k]) * arg_in(a, I_WDOWN)[eo + (size_t)k * DM + c];
      if (dbg_bad8(bf2f(((const bf16_t*)(a.ws + WS_ATT))[(size_t)yr * DM + c]), s)) dbg_fail(a, id + 1); }
}
__device__ __forceinline__ void dbg_chk_topk(const Args& a, bool last, int id, unsigned char* lds) {
    const TI ti = mk_ti(); float* red = (float*)lds; int* redi = (int*)(lds + 4096);
    const int np = last ? 32 : 64;
    for (int q = blockIdx.x; q < np; q += gridDim.x) { const bool isctx = q >= 32; const int g = isctx ? q - 32 : q, b = g >> 4, e = g & 15, n = isctx ? CTXL : SEQ, k = isctx ? CAPC : CAPL;
        const float* aff = (const float*)(a.ws + WS_AFF) + (size_t)g * RB + (isctx ? 0 : CTXL); const int* SLOT = (const int*)(a.ws + WS_SLOT); const int tok0 = b * RB + (isctx ? 0 : CTXL);
        float mns = 1e30f, mxu = -1e30f; int cnt = 0;
        for (int i = ti.tid; i < n; i += NTHREADS) { const int s = SLOT[(size_t)(tok0 + i) * 16 + e]; if (s >= 0) { mns = fminf(mns, aff[i]); ++cnt; } else mxu = fmaxf(mxu, aff[i]); }
        red[ti.tid] = mns; red[512 + ti.tid] = mxu; redi[ti.tid] = cnt; __syncthreads();
        if (ti.tid == 0) { float A = 1e30f, B = -1e30f; int C = 0; for (int i = 0; i < NTHREADS; ++i) { A = fminf(A, red[i]); B = fmaxf(B, red[512 + i]); C += redi[i]; } if (C != k || A < B) dbg_fail(a, id); }
        __syncthreads(); }
}
template <int DK>
__device__ __forceinline__ void dbg_attn_row(const bf16_t* Q, int qp, int qc, const bf16_t* K, int kp, int kc, const bf16_t* V, int vp, int vc, size_t rowb, int t, bool window, float sink2, float (&o)[64]) {
    float q[DK];
#pragma unroll
    for (int d = 0; d < DK; ++d) q[d] = bf2f(Q[(rowb + t) * qp + qc + d]);
    float m = -1e30f, l = 0.f;
#pragma unroll
    for (int d = 0; d < 64; ++d) o[d] = 0.f;
    const int nk = t < CTXL ? CTXL : RB;
    for (int kk = 0; kk < nk; ++kk) {
        const bf16_t* kr = K + (rowb + kk) * kp + kc; float s = 0.f;
#pragma unroll
        for (int d = 0; d < DK; ++d) s += q[d] * bf2f(kr[d]);
        const bool valid = !(window && t >= CTXL && kk >= CTXL && (kk - t > 128 || t - kk > 128));
        if (valid) { const float mn = fmaxf(m, s), f = exp2f(m - mn), p = exp2f(s - mn); l = l * f + p; const bf16_t* vr = V + (rowb + kk) * vp + vc;
#pragma unroll
            for (int d = 0; d < 64; ++d) o[d] = o[d] * f + p * bf2f(vr[d]);
            m = mn; }
    }
    l += exp2f(sink2 - m);
    const float il = 1.f / l;
#pragma unroll
    for (int d = 0; d < 64; ++d) o[d] *= il;
}
__device__ __forceinline__ void dbg_chk_attn(const Args& a, int l, bool last, int id) {
    const TI ti = mk_ti(); const bf16_t* AT = (const bf16_t*)(a.ws + WS_ATT); const bf16_t* PROJ = (const bf16_t*)(a.ws + WS_PROJ); const bf16_t* MIX = (const bf16_t*)(a.ws + WS_MIX);
    const int mixer = ti.gw & 3, bh = (ti.gw >> 2) & 7, b = bh >> 2, h = bh & 3; const size_t rowb = (size_t)b * RB;
    int t = CTXL + (((ti.gw >> 5) * 64 + ti.lane) * 131 + 7) % SEQ; if (!last && (ti.gw >> 5) == 0) t = (ti.lane * 37) % CTXL;
    float o[64], ref[64];
    if (mixer == 0) dbg_attn_row<64>(AT + AO_QA, 256, h * 64, AT + AO_KA, 128, (h >> 1) * 64, PROJ, INCP, PA_V + (h >> 1) * 64, rowb, t, true, arg_in(a, I_ASINK)[l * 4 + h] * LOG2E, o);
    else if (mixer == 1) dbg_attn_row<96>(AT + AO_QB, 384, h * 96, AT + AO_KB, 384, h * 96, AT + AO_VB, 256, h * 64, rowb, t, false, -1e30f, o);
    else if (mixer == 3) dbg_attn_row<64>(AT + AO_QD, 256, h * 64, AT + AO_KD, 128, (h >> 1) * 64, PROJ, INCP, PD_V + (h >> 1) * 64, rowb, t, false, -1e30f, o);
    else { dbg_attn_row<32>(AT + AO_QC, 256, h * 64, AT + AO_KC, 256, h * 64, PROJ, INCP, PC_V + h * 64, rowb, t, false, -1e30f, ref);
           dbg_attn_row<32>(AT + AO_QC, 256, h * 64 + 32, AT + AO_KC, 256, h * 64 + 32, PROJ, INCP, PC_V + h * 64, rowb, t, false, -1e30f, o);
           const float lam = (DBGLAM < -99.f ? ((const float*)(a.ws + WS_LAM))[l] : DBGLAM), omul = 1.f - (0.8f - 0.6f * __expf(-0.3f * (float)l)); float ss = 0.f;
#pragma unroll
           for (int d = 0; d < 64; ++d) { o[d] = ref[d] - lam * o[d]; ss += o[d] * o[d]; }
           const float rs = rsqrtf(ss * (1.f / 64.f) + EPS);
#pragma unroll
           for (int d = 0; d < 64; ++d) o[d] = o[d] * rs * arg_in(a, I_CSUBLN)[l * 64 + d] * omul; }
    const int oo = mixer == 0 ? 0 : mixer == 1 ? 256 : mixer == 2 ? 512 : 768; float err = 0.f, nrm = 0.f;
#pragma unroll
    for (int d = 0; d < 64; ++d) { const float g = bf2f(MIX[(rowb + t) * DM + oo + h * 64 + d]); err += (g - o[d]) * (g - o[d]); nrm += o[d] * o[d]; }
    if (!(err <= 1e-3f * nrm + 1e-7f)) dbg_fail(a, id + mixer);
}
#endif
#ifndef PHMASK
#define PHMASK 0xFFFF
#endif
#define PHON(b) ((PHMASK >> (b)) & 1)
#ifndef DBGMIX
#define DBGMIX 0
#endif
#define MIXON(b) (((DBGMIX >> (b)) & 1) ? 0.f : 1.f)
#ifndef DBGS_A0
#define DBGS_A0 1.f
#define DBGS_A1 1.f
#define DBGS_M0 1.f
#define DBGS_M1 1.f
#endif
#ifndef DBGNOCTX
#define DBGNOCTX 0
#endif
#ifndef DBGLAM
#define DBGLAM -100.f
#endif
#ifndef DBGFORCE
#define DBGFORCE 0
#endif
#ifndef BGHOOKS
#define BGHOOKS 1
#endif
#ifndef DUPROWSONLY
#define DUPROWSONLY 1
#endif
#ifndef EXTRABAR
#define EXTRABAR 0
#endif
#ifndef LOCTEST
#define LOCTEST 0
#endif
#ifndef DUPMASK
#define DUPMASK 0
#endif
#ifndef SPLITCTX
#define SPLITCTX 1
#endif
#ifndef DBGSKIP
#define DBGSKIP 0
#endif
constexpr int STEPS_PER_LAYER = 11, NSTEPS = 1 + DEPTH * STEPS_PER_LAYER;

__global__ void __launch_bounds__(NTHREADS, 2) fwd_kernel(const float* p0, const float* p1, const float* p2, const float* p3, const float* p4, const float* p5, const float* p6, const float* p7, const float* p8, const float* p9, const float* p10, const float* p11, const float* p12, const float* p13, const float* p14, const float* p15, const float* p16, const float* p17, const float* p18, const float* p19, const float* p20, const float* p21, const float* p22, const float* p23, float* p_out, unsigned char* p_ws, int p_lo, int p_hi) {
    extern __shared__ __attribute__((aligned(16))) unsigned char lds[];
    Args args; args.ka = (kaptr_t)__builtin_amdgcn_kernarg_segment_ptr(); args.out = p_out; args.ws = p_ws; args.lo = p_lo; args.hi = p_hi;
    const int G = gridDim.x, bx = blockIdx.x;
    const bool split = SPLITCTX && G >= 128;
    volatile LAS unsigned* MISC = (volatile LAS unsigned*)((LAS unsigned char*)lds + MISC_OFF);
    if (threadIdx.x < 64) MISC[threadIdx.x] = 0u;
    __syncthreads();
#if DBGCHK
    if (args.lo >= 100) {
        const int kind = args.lo - 100, l = args.hi; const bool last = (l == DEPTH - 1); const int id0 = l * 12;
        if (kind == 0) dbg_chk_inproj(args, l, id0 + 0);
        else if (kind == 1) dbg_chk_bup(args, l, id0 + 1);
        else if (kind == 2) dbg_chk_attn(args, l, last, id0 + 3);
        else if (kind == 3) dbg_chk_topk(args, last, id0 + 9, lds);
        else if (kind == 4) dbg_chk_moe(args, l, last, id0 + 7);
        return;
    }
#endif
    const bool coop = (args.hi - args.lo) > 1;
    XcdBarrier bar; bar.bar = (unsigned*)(args.ws + WS_CTL); bar.x = 0; bar.st = nullptr;
    if (coop) bar = xcd_barrier_post((unsigned*)(args.ws + WS_CTL), MISC + 8);
    bool duprep = false;
    for (int step = args.lo; step < args.hi; ++step) {
        Args la = args; { size_t z_ = 0; asm volatile("" : "+s"(z_)); la.ws = args.ws + z_; la.ka = args.ka + z_; }
        unsigned char* ws = la.ws; bf16_t* AT = (bf16_t*)(ws + WS_ATT);
        const int l = step == 0 ? 0 : (step - 1) / STEPS_PER_LAYER, s = step == 0 ? -1 : (step - 1) % STEPS_PER_LAYER;
        const bool last = (l == DEPTH - 1);
        if (s == 0 && l > 0) continue;
        if (PHON(0) && step == 0) p0_prologue(la, lds);
        else if (PHON(1) && s == 0) p1_norm1_l0(la);
        if (PHON(2) && (s == 1 || s == 2)) {
            if (!(DUPROWSONLY && duprep && s == 2)) {
                pg8::Gemm g; pg8::Sched S; pg8::EpiBf16 E;
                if (s == 1) { g = pg8::Gemm{(const bf16_t*)(ws + WS_H), (const bf16_t*)(ws + WS_WIN) + (size_t)l * INCP * DM, DM, DM, DM, nullptr, 0, 0}; S.init(NR / 256, INCP / 256, G, bx, 0); E = pg8::EpiBf16{(bf16_t*)(ws + WS_PROJ), INCP, 0}; }
                else if (s == 2) { g = pg8::Gemm{(const bf16_t*)(ws + WS_PROJ) + PB_CQ, (const bf16_t*)(ws + WS_WUQ) + (size_t)l * 2 * 512 * 256, INCP, 256, 256, nullptr, (size_t)512 * 256, (size_t)(PB_CKV - PB_CQ)};
                    S.init(132, 2, G, bx, 3); E = pg8::EpiBf16{AT + AO_QBR, 512, (size_t)NR * 512}; }
                pg8::gemm_phase<pg8::EpiBf16, false>((LAS unsigned char*)lds, (LAS int*)((LAS unsigned char*)lds + GIDX_OFF), g, S, E);
                if (BGHOOKS && s != 2 && (S.units() < S.max_units() || S.nwg % G == 0)) { const int rk = S.c - S.nwg % G, nrk = G - S.nwg % G;
                    if (l == 0) bg_convert(la, 0, 0, BG0_A, rk, nrk, lds); else bg_convert(la, 1, BG1_U + BG1_D, BG1_A, rk, nrk, lds); }
            }
            if (PHON(3) && s == 2) { const int nbusy = (264 > G && 264 <= 2 * G) ? 264 - G : 0;
                if (bx >= nbusy) p3_rows(la, l, bx - nbusy, G - nbusy); }
        }
        if (PHON(3) && s == 3) p3c_rows(la);
        if (PHON(4) && s == 4) {
            const float* LAMv = (const float*)(ws + WS_LAM);
            const bf16_t* PROJ = (const bf16_t*)(ws + WS_PROJ); bf16_t* MIX = (bf16_t*)(ws + WS_MIX);
            const int nu = 256 + (last ? 0 : 8);
            if (PHON(10)) { const att::Desc D{AT + AO_QB, 384, 0, AT + AO_KB, 384, 0, AT + AO_VB, 256, 0, MIX, 256};
              unsigned redo = 0u;
              for (int u = bx, i = 0; u < nu; u += G, ++i) { const bool cx = u >= 256; const int bh = cx ? u - 256 : (LOCTEST ? (u >> 5) : (u & 7)), b = bh >> 2, h = bh & 3, qt0 = cx ? 0 : 256 * ((LOCTEST ? (u & 31) : (u >> 3)) + 1);
                  if (att::attn_unit_d<1, 6, false, true>(D, b, h, h, h, qt0, cx ? 4 : 132, 4, false, att::NEGBIG, 0.f, nullptr, MIXON(1), lds) || (DBGFORCE && (u & 1))) redo |= 1u << (i & 31); }
              if (redo) for (int u = bx, i = 0; u < nu; u += G, ++i) if ((redo >> (i & 31)) & 1u) { const bool cx = u >= 256; const int bh = cx ? u - 256 : (LOCTEST ? (u >> 5) : (u & 7)), b = bh >> 2, h = bh & 3, qt0 = cx ? 0 : 256 * ((LOCTEST ? (u & 31) : (u >> 3)) + 1);
                  att::attn_unit<1, 6, false>(D, b, h, h, h, qt0, cx ? 4 : 132, 4, false, att::NEGBIG, 0.f, nullptr, MIXON(1), lds); } }
            if (PHON(11)) { const att::Desc D{AT + AO_QC, 256, 0, AT + AO_KC, 256, 0, PROJ, INCP, PC_V, MIX, 512};
              const float lam = (DBGLAM < -99.f ? LAMv[l] : DBGLAM), omul = (1.f - (0.8f - 0.6f * __expf(-0.3f * (float)l))) * MIXON(2);
              unsigned redo = 0u;
              for (int u = (bx + G - 8 % G) % G, i = 0; u < nu; u += G, ++i) { const bool cx = u >= 256; const int bh = cx ? u - 256 : (LOCTEST ? (u >> 5) : (u & 7)), b = bh >> 2, h = bh & 3, qt0 = cx ? 0 : 256 * ((LOCTEST ? (u & 31) : (u >> 3)) + 1);
                  if (att::attn_unit<2, 2, false, true>(D, b, h, h, h, qt0, cx ? 4 : 132, 4, false, att::NEGBIG, lam, arg_in(la, I_CSUBLN) + l * 64, omul, lds) || (DBGFORCE && (u & 1))) redo |= 1u << (i & 31); }
              if (redo) for (int u = (bx + G - 8 % G) % G, i = 0; u < nu; u += G, ++i) if ((redo >> (i & 31)) & 1u) { const bool cx = u >= 256; const int bh = cx ? u - 256 : (LOCTEST ? (u >> 5) : (u & 7)), b = bh >> 2, h = bh & 3, qt0 = cx ? 0 : 256 * ((LOCTEST ? (u & 31) : (u >> 3)) + 1);
                  att::attn_unit<2, 2, false>(D, b, h, h, h, qt0, cx ? 4 : 132, 4, false, att::NEGBIG, lam, arg_in(la, I_CSUBLN) + l * 64, omul, lds); } }
            if (PHON(12)) for (int mx = 0; mx < 2; ++mx) {
                const att::Desc D = mx == 0 ? att::Desc{AT + AO_QD, 256, 0, AT + AO_KD, 128, 0, PROJ, INCP, PD_V, MIX, 768} : att::Desc{AT + AO_QA, 256, 0, AT + AO_KA, 128, 0, PROJ, INCP, PA_V, MIX, 0};
                unsigned redo = 0u;
                for (int pass = 0; pass < 2; ++pass) { if (pass == 1 && redo == 0u) break;
                for (int u = (bx + G - (16 + 8 * mx) % G) % G, i = 0; u < nu; u += G, ++i) { if (pass == 1 && !((redo >> (i & 31)) & 1u)) continue;
                    const bool cx = u >= 256; const int bh = cx ? u - 256 : (LOCTEST ? (u >> 5) : (u & 7)), b = bh >> 2, h = bh & 3, qb = (LOCTEST ? (u & 31) : (u >> 3)) + 1, qt0 = cx ? 0 : 256 * qb;
                    int ntile = cx ? 4 : 132, wstart = 4; bool win = false; float sink2 = att::NEGBIG;
                    if (mx == 1) { sink2 = arg_in(la, I_ASINK)[l * 4 + h] * LOG2E;
                        if (!cx) { const int ws_ = (4 * qb - 2) < 4 ? 4 : (4 * qb - 2), we_ = (4 * qb + 5) > 131 ? 131 : (4 * qb + 5); wstart = ws_; ntile = 4 + we_ - ws_ + 1; win = true; } }
                    if (pass == 0) { if (att::attn_unit_d<1, 4, true, true>(D, b, h, h >> 1, h >> 1, qt0, ntile, wstart, win, sink2, 0.f, nullptr, mx == 0 ? MIXON(3) : MIXON(0), lds) || (DBGFORCE && (u & 1))) redo |= 1u << (i & 31); }
                    else att::attn_unit<1, 4, true>(D, b, h, h >> 1, h >> 1, qt0, ntile, wstart, win, sink2, 0.f, nullptr, mx == 0 ? MIXON(3) : MIXON(0), lds); } } }
        }
        const bool ctxgemm = (s == 6 && !last && split && bx < 8);
        if (PHON(5) && (s == 5 || ctxgemm)) {
            pg8::Gemm g{(const bf16_t*)(ws + WS_MIX), (const bf16_t*)(ws + WS_WOUT) + (size_t)l * DM * DM, DM, DM, DM, nullptr, 0, 0};
            pg8::Sched S; if (s == 5) S.init((last || split) ? 64 : 66, 4, G, bx, (last || split) ? 1 : 0); else S.init(2, 4, 8, bx, 4);
            pg8::EpiResid E{(bf16_t*)(ws + WS_X), (const float*)(ws + WS_MOD) + (size_t)l * 3 * 6144 + 2048, 6144, duprep ? 0.f : (l == 0 ? DBGS_A0 : DBGS_A1)};
            pg8::gemm_phase<pg8::EpiResid, false>((LAS unsigned char*)lds, (LAS int*)((LAS unsigned char*)lds + GIDX_OFF), g, S, E);
            if (BGHOOKS && s == 5 && l == 0 && BG0_B > 0 && (S.units() < S.max_units() || S.nwg % G == 0)) bg_convert(la, 0, BG0_A, BG0_B, S.c - S.nwg % G, G - S.nwg % G, lds);
        }
        { int p6rows = -1, p6rank = 0, p6n = 1;
          if (s == 6 && !ctxgemm) { if (!last && split) { p6rows = 1; p6rank = bx - 8; p6n = G - 8; } else { p6rows = 0; p6rank = bx; p6n = G; } }
          if (s == 7 && !last && split && bx >= 64 && bx < 128) { p6rows = 2; p6rank = bx - 64; p6n = 64; }
          if (PHON(6) && p6rows >= 0) p6_norm2_router(la, l, last, p6rows, p6rank, p6n, lds); }
        if (PHON(7) && s == 7) { const int np = last ? 32 : 64;
            unsigned* ctxcnt = (unsigned*)(ws + WS_BGCNT);
            if (!last && split && bx >= 64 && bx < 128) {
                if (threadIdx.x == 0 && !duprep) { __builtin_amdgcn_fence(__ATOMIC_RELEASE, "agent"); asm volatile("s_waitcnt vmcnt(0)" ::: "memory"); (void)xb_add(ctxcnt, 1u); } }
            if (!last && split && bx >= 32 && bx < 64) {
                if (threadIdx.x == 0) { unsigned sp = 0u; while (xb_ld(ctxcnt) < 64u && ++sp < XB_SPIN_CAP) __builtin_amdgcn_s_sleep(1);
                    __builtin_amdgcn_fence(__ATOMIC_ACQUIRE, "agent"); asm volatile("s_waitcnt vmcnt(0)" ::: "memory"); }
                __syncthreads(); }
            for (int q = bx; q < np; q += G) p7_topk(la, q, lds);
            { const int first = BGHOOKS ? (l == 0 ? BG0_A + BG0_B : BG1_U + BG1_D + BG1_A) : 0;
              if (G > np) { if (bx >= np) bg_convert(la, l, first, CI_MOE - first, bx - np, G - np, lds); } else bg_convert(la, l, first, CI_MOE - first, bx, G, lds); } }
        if (PHON(8) && s == 8) {
            pg8::Gemm g{(const bf16_t*)(ws + WS_H), (const bf16_t*)(ws + WS_WGU + (size_t)l * WS_WL), DM / 2, DM / 2, DM / 2, (const int*)(ws + WS_IDX), (size_t)2048 * DM / 2, 0};
            pg8::Sched S; S.init(last ? 128 : 144, 8, G, bx, 2);
            pg8::EpiSwiGLU8 E{ws + WS_PROJ, DM};
            pg8::gemm_phase<pg8::EpiSwiGLU8, true, true>((LAS unsigned char*)lds, (LAS int*)((LAS unsigned char*)lds + GIDX_OFF), g, S, E);
            if (BGHOOKS && !last && (S.units() < S.max_units() || S.nwg % G == 0)) bg_convert(la, l + 1, 0, BG1_U, S.c - S.nwg % G, G - S.nwg % G, lds);
        }
        if (PHON(2) && s == 9) {
            pg8::Gemm g{(const bf16_t*)(ws + WS_PROJ), (const bf16_t*)(ws + WS_WDN + (size_t)l * WS_WL), DM / 2, DM / 2, DM / 2, nullptr, (size_t)DM * DM / 2, 0};
            pg8::Sched S; S.init(last ? 128 : 144, 4, G, bx, 2);
            pg8::EpiBf16 E{(bf16_t*)(ws + WS_ATT), DM, 0};
            pg8::gemm_phase<pg8::EpiBf16, false, true>((LAS unsigned char*)lds, (LAS int*)((LAS unsigned char*)lds + GIDX_OFF), g, S, E);
            if (BGHOOKS && !last && (S.units() < S.max_units() || S.nwg % G == 0)) bg_convert(la, l + 1, BG1_U, BG1_D, S.c - S.nwg % G, G - S.nwg % G, lds);
        }
        if (PHON(9) && s == 10) {
            float dbgmul = 1.f;
#if DBGCHK
            if (last) { const int* fl = (const int*)(ws + WS_DBG); for (int q = 31; q >= 0; --q) if (fl[q] != 0) dbgmul = 2.f + (float)q; }
#endif
            p10_combine(la, l, last, duprep ? 0.f : (l == 0 ? DBGS_M0 : DBGS_M1), dbgmul);
        }
        if (step + 1 < args.hi) xcd_barrier(bar);
        if (EXTRABAR && step + 1 < args.hi && step == 1) for (int q = 0; q < EXTRABAR; ++q) xcd_barrier(bar);
        if (DUPMASK != 0) { const int bit = step == 0 ? 11 : s; if (((DUPMASK >> bit) & 1) && !duprep) { duprep = true; --step; } else duprep = false; }
    }
}

extern "C" void kernel_launch(void* const* d_in, const int* in_sizes, int n_in, void* d_out, int out_size, void* d_ws, size_t ws_size, hipStream_t stream) {
    static int grid = 0;
    if (grid == 0) {
        if (n_in != 24 || out_size != NBATCH * SEQ * DM || ws_size < WS_END) { fprintf(stderr, "kernel_launch: unexpected shapes (n_in %d, out %d, ws %zu < %zu); nothing launched\n", n_in, out_size, ws_size, (size_t)WS_END); grid = -1; return; }
        int dev = 0, cus = 0, per_cu = 0;
        if (hipGetDevice(&dev) != hipSuccess || hipDeviceGetAttribute(&cus, hipDeviceAttributeMultiprocessorCount, dev) != hipSuccess) { grid = -1; return; }
        if (hipFuncSetAttribute((const void*)fwd_kernel, hipFuncAttributeMaxDynamicSharedMemorySize, LDS_BYTES) != hipSuccess) { fprintf(stderr, "kernel_launch: hipFuncSetAttribute failed\n"); grid = -1; return; }
        if (hipOccupancyMaxActiveBlocksPerMultiprocessor(&per_cu, (const void*)fwd_kernel, NTHREADS, LDS_BYTES) != hipSuccess || per_cu < 1) { fprintf(stderr, "kernel_launch: occupancy query says %d blocks per CU\n", per_cu); (void)hipGetLastError(); per_cu = 1; }
        grid = cus;
    }
    if (grid < 0) return;
    (void)hipMemsetAsync((char*)d_ws + WS_CTL, 0, CTL_ZERO_BYTES, stream);
    const float* pin[24]; for (int i = 0; i < 24; ++i) pin[i] = (const float*)d_in[i];
    float* pout = (float*)d_out; unsigned char* pws = (unsigned char*)d_ws; int lo = 0, hi = NSTEPS;
    void* kargs[28]; for (int i = 0; i < 24; ++i) kargs[i] = (void*)&pin[i];
    kargs[24] = (void*)&pout; kargs[25] = (void*)&pws; kargs[26] = (void*)&lo; kargs[27] = (void*)&hi;
#if MK_LAUNCHES == 1
    hipError_t e = hipLaunchKernel((const void*)fwd_kernel, dim3(grid), dim3(NTHREADS), kargs, LDS_BYTES, stream);
    if (e != hipSuccess) fprintf(stderr, "kernel_launch: launch failed: %s (grid %d)\n", hipGetErrorString(e), grid);
#else
    for (int st = 0; st < NSTEPS; ++st) {
        if (st > 1 && (st - 1) % STEPS_PER_LAYER == 0) continue;
        lo = st; hi = st + 1;
        (void)hipLaunchKernel((const void*)fwd_kernel, dim3(grid), dim3(NTHREADS), kargs, LDS_BYTES, stream);
#if DBGCHK
        if (st >= 1) { const int l_ = (st - 1) / STEPS_PER_LAYER, s_ = (st - 1) % STEPS_PER_LAYER; const int kind = s_ == 1 ? 0 : s_ == 2 ? 1 : s_ == 4 ? 2 : s_ == 7 ? 3 : s_ == 9 ? 4 : -1;
            if (kind >= 0) { lo = 100 + kind; hi = l_; (void)hipLaunchKernel((const void*)fwd_kernel, dim3(grid), dim3(NTHREADS), kargs, LDS_BYTES, stream); } }
#endif
    }
#endif
}
```

```cpp
#include <hip/hip_runtime.h>
#include <cstdio>
#include <cstdint>

#ifndef MK_LAUNCHES
#define MK_LAUNCHES 1
#endif

#ifndef DBGLAM
#define DBGLAM -100.f
#endif
#ifndef DBGCHK
#define DBGCHK 0
#endif
#define GAS __attribute__((address_space(1)))
#define LAS __attribute__((address_space(3)))
typedef unsigned short bf16_t;
typedef short bf16x8 __attribute__((ext_vector_type(8)));
typedef short s16x4 __attribute__((ext_vector_type(4)));
typedef float f32x4 __attribute__((ext_vector_type(4)));
typedef float f32x2 __attribute__((ext_vector_type(2)));
typedef float f32x16 __attribute__((ext_vector_type(16)));
typedef unsigned u32x4 __attribute__((ext_vector_type(4)));
typedef unsigned u32x2 __attribute__((ext_vector_type(2)));
typedef int i32x4 __attribute__((ext_vector_type(4)));
typedef int i32x8 __attribute__((ext_vector_type(8)));

constexpr int DM = 1024, NBATCH = 2, SEQ = 8192, CTXL = 256, DEPTH = 2;
constexpr int RB = SEQ + CTXL;
constexpr int NR = NBATCH * RB;
constexpr int INC = 2144, INCP = 2304;
constexpr int NEXP = 16, CAPL = 1024, CAPC = 32;
constexpr int YROWS = (128 + 16) * 256;
constexpr float EPS = 1e-6f;
constexpr float LOG2E = 1.4426950408889634f;
constexpr int PA_Q = 0, PA_K = 256, PA_V = 384;
constexpr int PB_CQ = 512, PB_CKV = 704, PB_KR = 832;
constexpr int PC_Q = 864, PC_K = 1120, PC_V = 1376;
constexpr int PD_Q = 1632, PD_K = 1888, PD_V = 2016;

constexpr size_t MiB = 1u << 20;
constexpr size_t WS_CTL = 0, CTL_ZERO_BYTES = 64 * 1024;
constexpr size_t WS_MOD   = 1 * MiB;
constexpr size_t WS_LAM   = WS_MOD + 160 * 1024;
constexpr size_t WS_TAB64 = WS_MOD + 192 * 1024;
constexpr size_t WS_TAB32 = WS_MOD + 224 * 1024;
constexpr size_t WS_RS    = WS_MOD + 256 * 1024;
constexpr size_t WS_GATEY = WS_MOD + 512 * 1024;
constexpr size_t WS_IDX   = WS_MOD + 768 * 1024;
constexpr size_t WS_AFF   = 2 * MiB;
constexpr size_t WS_SLOT  = 4 * MiB;
constexpr size_t WS_WIN   = 8 * MiB;
constexpr size_t WS_WOUT  = 18 * MiB;
constexpr size_t WS_WUQ   = 22 * MiB;
constexpr size_t WS_WGU   = 24 * MiB;
constexpr size_t WS_WDN   = 88 * MiB;
constexpr size_t WS_WL    = 96 * MiB;
constexpr size_t WS_X     = 216 * MiB;
constexpr size_t WS_H     = 282 * MiB;
constexpr size_t WS_PROJ  = 315 * MiB;
constexpr size_t WS_ATT   = 391 * MiB;
constexpr size_t WS_END   = 499 * MiB;
constexpr size_t AO_QA = 0, AO_KA = AO_QA + (size_t)NR * 256, AO_QBR = AO_KA + (size_t)NR * 128, AO_KVBR = AO_QBR + (size_t)NR * 512,
                 AO_QB = AO_KVBR + (size_t)NR * 512, AO_KB = AO_QB + (size_t)NR * 384, AO_VB = AO_KB + (size_t)NR * 384,
                 AO_QC = AO_VB + (size_t)NR * 256, AO_KC = AO_QC + (size_t)NR * 256, AO_QD = AO_KC + (size_t)NR * 256, AO_KD = AO_QD + (size_t)NR * 256,
                 AO_END = AO_KD + (size_t)NR * 128;
static_assert(WS_ATT + AO_END * 2 <= WS_END, "attention operands fit");
constexpr size_t WS_MIX = WS_ATT + AO_QBR * 2;
static_assert(AO_KVBR - AO_QBR == (size_t)NR * 512 && AO_QB - AO_KVBR == (size_t)NR * 512 && (WS_MIX % 16) == 0, "MIX overlay");
constexpr size_t WS_BGCNT = 40 * 1024;
static_assert((size_t)YROWS * 1024 * 2 <= WS_ATT - WS_PROJ && (size_t)YROWS * 1024 * 2 <= WS_END - WS_ATT, "ACT / Y overlays fit");

constexpr int RING_BYTES = 131072;
constexpr int GIDX_OFF = RING_BYTES;
constexpr int MISC_OFF = RING_BYTES + 8192;
constexpr int LDS_BYTES = 147456;
constexpr int NTHREADS = 512, NWAVES = 8;

#define LDS_WAIT() asm volatile("s_waitcnt lgkmcnt(0)" ::: "memory")
#define VM_WAIT() asm volatile("s_waitcnt vmcnt(0)" ::: "memory")
__device__ __forceinline__ unsigned f2bf(float f) { unsigned u = __builtin_bit_cast(unsigned, f); return (u + 0x7fffu + ((u >> 16) & 1u)) >> 16; }
__device__ __forceinline__ unsigned pk2(float lo, float hi) { return f2bf(lo) | (f2bf(hi) << 16); }
__device__ __forceinline__ float bf2f(unsigned h) { return __builtin_bit_cast(float, h << 16); }
__device__ __forceinline__ float bflo(unsigned w) { return __builtin_bit_cast(float, w << 16); }
__device__ __forceinline__ float bfhi(unsigned w) { return __builtin_bit_cast(float, w & 0xffff0000u); }
__device__ __forceinline__ float shx(float v, int o, int lane) { return __builtin_bit_cast(float, __builtin_amdgcn_ds_bpermute((lane ^ o) << 2, __builtin_bit_cast(int, v))); }
__device__ __forceinline__ int shxi(int v, int o, int lane) { return __builtin_amdgcn_ds_bpermute((lane ^ o) << 2, v); }
__device__ __forceinline__ int shidx(int v, int src) { return __builtin_amdgcn_ds_bpermute(src << 2, v); }
template <int CTRL, int RM>
__device__ __forceinline__ float dppf(float v) { return __builtin_bit_cast(float, __builtin_amdgcn_update_dpp(0, __builtin_bit_cast(int, v), CTRL, RM, 0xF, true)); }
__device__ __forceinline__ float wave_sum(float v, int  ) {
    v += dppf<0x111, 0xF>(v); v += dppf<0x112, 0xF>(v); v += dppf<0x114, 0xF>(v); v += dppf<0x118, 0xF>(v);
    v += dppf<0x142, 0xA>(v); v += dppf<0x143, 0xC>(v);
    return __builtin_bit_cast(float, __builtin_amdgcn_readlane(__builtin_bit_cast(int, v), 63));
}
__device__ __forceinline__ float wave_sum_bp(float v, int lane) {
#pragma unroll
    for (int o = 1; o < 64; o <<= 1) v += shx(v, o, lane);
    return v;
}
__device__ __forceinline__ float quad_sum(float v) { v += dppf<0xB1, 0xF>(v); v += dppf<0x4E, 0xF>(v); return v; }
__device__ __forceinline__ float half_sum(float v, int lane) {
#pragma unroll
    for (int o = 1; o < 32; o <<= 1) v += shx(v, o, lane);
    return v;
}
constexpr float W8_MUL = 32.f;
constexpr int W8_SCALE = 0x7a7a7a7a, A8_SCALE = 0x7f7f7f7f;
__device__ __forceinline__ float clamp8(float x) { return __builtin_amdgcn_fmed3f(x, -448.f, 448.f); }
__device__ __forceinline__ unsigned pk4_fp8(float a, float b, float c, float d) { int w = 0; w = __builtin_amdgcn_cvt_pk_fp8_f32(clamp8(a), clamp8(b), w, false); w = __builtin_amdgcn_cvt_pk_fp8_f32(clamp8(c), clamp8(d), w, true); return (unsigned)w; }
__device__ __forceinline__ f32x4 ldx4(const bf16_t* p) { const u32x2 w = *(const u32x2*)p; return (f32x4){bflo(w.x), bfhi(w.x), bflo(w.y), bfhi(w.y)}; }
__device__ __forceinline__ void stx4(bf16_t* p, const f32x4& v) { u32x2 w; w.x = pk2(v.x, v.y); w.y = pk2(v.z, v.w); *(u32x2*)p = w; }
__device__ __forceinline__ float siluf(float x) { return x / (1.f + __expf(-x)); }
namespace pg8 {
constexpr int BM = 256, BK = 64, HALF = 128, HTB = HALF * BK * 2  , STAGE_BYTES = 8 * HTB, NXCD = 8, WGM = 8;

__host__ __device__ __forceinline__ int lds_byte(int r, int c) { const int st = (r >> 4) * 2 + (c >> 5), rr = r & 15, cc = c & 31, ob = rr * 64 + cc * 2; return st * 1024 + (ob ^ (((ob >> 9) & 1) << 5)); }
__host__ __device__ __forceinline__ void stage_rc(int b, int& R, int& C) { const int st = b / 1024, sb = b % 1024, swz = sb ^ (((sb >> 9) & 1) << 5); R = (st >> 1) * 16 + swz / 64; C = (st & 1) * 32 + (swz % 64) / 2; }
__host__ __device__ __forceinline__ int perm32(int rho) { const int n = rho >> 4, i = rho & 15; return 8 * (i >> 2) + 4 * n + (i & 3); }

struct Unit { int pm, pn, e; };
struct Gemm { const bf16_t* A; const bf16_t* Bt; int lda, ldb, K; const int* gidx; size_t bstride_e; size_t astride_e; };

struct Sched {
    int nM, nN, nwg, G, c, mode;
    __device__ void init(int nM_, int nN_, int G_, int c_, int mode_) { nM = nM_; nN = nN_; nwg = nM * nN; G = G_; c = c_; mode = mode_; }
    __device__ int units() const { return c < nwg ? (nwg - 1 - c) / G + 1 : 0; }
    __device__ int max_units() const { return (nwg + G - 1) / G; }
    __device__ bool next(int i, Unit& u) const {
        const long L = (long)i * G + c; if (L >= nwg) return false;
        int wgid = (int)L; { const int q = nwg / NXCD, r = nwg % NXCD, xcd = wgid % NXCD, off = wgid / NXCD; wgid = (xcd < r ? xcd * (q + 1) : r * (q + 1) + (xcd - r) * q) + off; }
        const int nig = WGM * nN, gid = wgid / nig, fm = gid * WGM, gsz = (nM - fm) < WGM ? (nM - fm) : WGM;
        const int vm = fm + ((wgid % nig) % gsz); u.pn = (wgid % nig) / gsz;
        int pm = vm, e = 0;
        if (mode == 1) pm = vm + 1 + (vm >= 32 ? 1 : 0);
        else if (mode == 2) { if (vm < 128) { pm = ((vm >> 2) & 1) * 64 + (vm >> 3) * 4 + (vm & 3); e = (pm >> 2) & 15; } else { pm = vm; e = vm - 128; } }
        else if (mode == 3) { e = vm / 66; pm = vm - e * 66; }
        else if (mode == 4) pm = vm * 33;
        u.pm = pm; u.e = e; return true;
    }
};

__device__ __forceinline__ unsigned cvt_pk_bf16(float lo, float hi) { unsigned r; asm volatile("v_cvt_pk_bf16_f32 %0, %1, %2" : "=v"(r) : "v"(lo), "v"(hi)); return r; }

struct EpiBf16 {
    static constexpr bool PERM = true;
    bf16_t* O; int ldc; size_t ostride_e;
    __device__ __forceinline__ void operator()(const f32x4 (&acc)[2][2][4][2], const Unit& u, int wr, int wc, int fr, int fq) const {
        const int row0 = u.pm * BM + wr * 64 + fr; const int col0 = u.pn * BM + wc * 32 + 8 * fq;
#pragma unroll
        for (int ai = 0; ai < 2; ++ai)
#pragma unroll
            for (int m = 0; m < 4; ++m) { bf16_t* rowp = O + (size_t)u.e * ostride_e + (size_t)(row0 + ai * HALF + m * 16) * ldc + col0;
#pragma unroll
                for (int bj = 0; bj < 2; ++bj) { const f32x4 v0 = acc[ai][bj][m][0], v1 = acc[ai][bj][m][1];
                    u32x4 w; w.x = cvt_pk_bf16(v0[0], v0[1]); w.y = cvt_pk_bf16(v0[2], v0[3]); w.z = cvt_pk_bf16(v1[0], v1[1]); w.w = cvt_pk_bf16(v1[2], v1[3]);
                    *(u32x4*)(rowp + bj * HALF) = w; } }
    }
};
struct EpiFp8 {
    static constexpr bool PERM = true;
    unsigned char* O; int ldc;
    __device__ __forceinline__ void operator()(const f32x4 (&acc)[2][2][4][2], const Unit& u, int wr, int wc, int fr, int fq) const {
        const int row0 = u.pm * BM + wr * 64 + fr; const int col0 = u.pn * BM + wc * 32 + 8 * fq;
#pragma unroll
        for (int ai = 0; ai < 2; ++ai)
#pragma unroll
            for (int m = 0; m < 4; ++m) { unsigned char* rowp = O + (size_t)(row0 + ai * HALF + m * 16) * ldc + col0;
#pragma unroll
                for (int bj = 0; bj < 2; ++bj) { const f32x4 v0 = acc[ai][bj][m][0], v1 = acc[ai][bj][m][1];
                    u32x2 w; w.x = pk4_fp8(v0[0], v0[1], v0[2], v0[3]); w.y = pk4_fp8(v1[0], v1[1], v1[2], v1[3]);
                    *(u32x2*)(rowp + bj * HALF) = w; } }
    }
};
struct EpiSwiGLU {
    static constexpr bool PERM = true;
    bf16_t* O; int ldc;
    __device__ __forceinline__ void operator()(const f32x4 (&acc)[2][2][4][2], const Unit& u, int wr, int wc, int fr, int fq) const {
        const int row0 = u.pm * BM + wr * 64 + fr; const int col0 = u.pn * HALF + wc * 32 + 8 * fq;
#pragma unroll
        for (int ai = 0; ai < 2; ++ai)
#pragma unroll
            for (int m = 0; m < 4; ++m) { bf16_t* rowp = O + (size_t)(row0 + ai * HALF + m * 16) * ldc + col0;
                float r[8];
#pragma unroll
                for (int n = 0; n < 2; ++n)
#pragma unroll
                    for (int j = 0; j < 4; ++j) { const float a = acc[ai][0][m][n][j], b = acc[ai][1][m][n][j]; r[n * 4 + j] = a * __builtin_amdgcn_rcpf(1.f + __builtin_amdgcn_exp2f(-a * LOG2E)) * b; }
                u32x4 w; w.x = cvt_pk_bf16(r[0], r[1]); w.y = cvt_pk_bf16(r[2], r[3]); w.z = cvt_pk_bf16(r[4], r[5]); w.w = cvt_pk_bf16(r[6], r[7]);
                *(u32x4*)rowp = w; }
    }
};
struct EpiSwiGLU8 {
    static constexpr bool PERM = true;
    unsigned char* O; int ldc;
    __device__ __forceinline__ void operator()(const f32x4 (&acc)[2][2][4][2], const Unit& u, int wr, int wc, int fr, int fq) const {
        const int row0 = u.pm * BM + wr * 64 + fr; const int col0 = u.pn * HALF + wc * 32 + 8 * fq;
#pragma unroll
        for (int ai = 0; ai < 2; ++ai)
#pragma unroll
            for (int m = 0; m < 4; ++m) { unsigned char* rowp = O + (size_t)(row0 + ai * HALF + m * 16) * ldc + col0;
                float r[8];
#pragma unroll
                for (int n = 0; n < 2; ++n)
#pragma unroll
                    for (int j = 0; j < 4; ++j) { const float a = acc[ai][0][m][n][j], b = acc[ai][1][m][n][j]; r[n * 4 + j] = a * __builtin_amdgcn_rcpf(1.f + __builtin_amdgcn_exp2f(-a * LOG2E)) * b; }
                u32x2 w; w.x = pk4_fp8(r[0], r[1], r[2], r[3]); w.y = pk4_fp8(r[4], r[5], r[6], r[7]);
                *(u32x2*)rowp = w; }
    }
};
struct EpiResid {
    static constexpr bool PERM = true;
    bf16_t* X; const float* gate; int gp; float dbg;
    __device__ __forceinline__ void operator()(const f32x4 (&acc)[2][2][4][2], const Unit& u, int wr, int wc, int fr, int fq) const {
        const int mr = (u.pm % 33 == 0) ? 2 : (u.pm / 33);
        const int col0 = u.pn * BM + wc * 32 + 8 * fq;
        f32x4 gv[2][2];
#pragma unroll
        for (int bj = 0; bj < 2; ++bj)
#pragma unroll
            for (int n = 0; n < 2; ++n) gv[bj][n] = *(const f32x4*)(gate + (size_t)mr * gp + col0 + bj * HALF + n * 4) * dbg;
#pragma unroll
        for (int ai = 0; ai < 2; ++ai)
#pragma unroll
            for (int m = 0; m < 4; ++m) { bf16_t* rowp = X + (size_t)(u.pm * BM + ai * HALF + wr * 64 + m * 16 + fr) * DM + col0;
                u32x4 xw[2];
#pragma unroll
                for (int bj = 0; bj < 2; ++bj) xw[bj] = *(const u32x4*)(rowp + bj * HALF);
#pragma unroll
                for (int bj = 0; bj < 2; ++bj) { const f32x4 a0 = acc[ai][bj][m][0], a1 = acc[ai][bj][m][1]; const u32x4 x = xw[bj]; u32x4 w;
                    w.x = cvt_pk_bf16(bflo(x.x) + gv[bj][0][0] * a0[0], bfhi(x.x) + gv[bj][0][1] * a0[1]); w.y = cvt_pk_bf16(bflo(x.y) + gv[bj][0][2] * a0[2], bfhi(x.y) + gv[bj][0][3] * a0[3]);
                    w.z = cvt_pk_bf16(bflo(x.z) + gv[bj][1][0] * a1[0], bfhi(x.z) + gv[bj][1][1] * a1[1]); w.w = cvt_pk_bf16(bflo(x.w) + gv[bj][1][2] * a1[2], bfhi(x.w) + gv[bj][1][3] * a1[3]);
                    *(u32x4*)(rowp + bj * HALF) = w; }
                asm volatile("" ::: "memory"); }
    }
};

__device__ __forceinline__ void mfma8(f32x4& acc, const i32x8 a, const i32x8 b, int sa, int sb) {
    asm volatile("v_mfma_scale_f32_16x16x128_f8f6f4 %0, %1, %2, %0, %3, %4 op_sel_hi:[0,0,0]" : "+v"(acc) : "v"(a), "v"(b), "v"(sa), "v"(sb));
}
template <class Epi, bool GATHER, bool FP8 = false>
__device__ __forceinline__ void gemm_phase(LAS unsigned char* lds, LAS int* gl, const Gemm g, const Sched& S, const Epi& E) {
    int tid_ = threadIdx.x; asm volatile("" : "+v"(tid_));
    const int tid = tid_, wid = __builtin_amdgcn_readfirstlane(tid >> 6), lane = tid & 63, wr = wid >> 2, wc = wid & 3, fr = lane & 15, fq = lane >> 4;
    const int K = g.K, nt = K / BK;
    int sc_w = W8_SCALE, sc_a = A8_SCALE; if constexpr (FP8) { asm volatile("" : "+v"(sc_w), "+v"(sc_a)); }
    int Rs[2], Cs[2]; unsigned voffB[2]; unsigned vAc[2][2], vAn[2][2];
#pragma unroll
    for (int i = 0; i < 2; ++i) { int R, C; stage_rc(tid * 16 + i * 8192, R, C); Rs[i] = R; Cs[i] = C; const int Rb = Epi::PERM ? ((R & ~31) + perm32(R & 31)) : R;
        voffB[i] = (unsigned)(Rb * g.ldb + C) * 2u;
#pragma unroll
        for (int h = 0; h < 2; ++h) { vAc[h][i] = (unsigned)((h * HALF + R) * g.lda + C) * 2u; vAn[h][i] = vAc[h][i]; } }
    const size_t kstep = (size_t)(BK * 2);
    const size_t hstepB = (size_t)HALF * g.ldb * 2;
    const unsigned ldsw = (unsigned)wid * 1024u;
    const int aoff = lds_byte(wr * 64 + fr, fq * 8), boff = lds_byte(wc * 32 + fr, fq * 8);
#define PG8_SA(b, h) (((b) * 2 + (h)) * HTB)
#define PG8_SB(b, h) ((4 + (b) * 2 + (h)) * HTB)
#define PG8_STAGE(bufoff, gbase, voff) do { _Pragma("unroll") for (int _i = 0; _i < 2; ++_i) \
        __builtin_amdgcn_global_load_lds((const unsigned*)((const char*)(gbase) + (voff)[_i]), (LAS unsigned*)(lds + (bufoff) + ldsw + _i * 8192), 16, 0, 0); } while (0)
#define PG8_LDA(dst, b, h) do { _Pragma("unroll") for (int m = 0; m < 4; ++m) _Pragma("unroll") for (int k = 0; k < 2; ++k) dst[m][k] = *(const LAS bf16x8*)(lds + PG8_SA(b, h) + aoff + m * 2048 + k * 1024); } while (0)
#define PG8_LDB(dst, b, h) do { _Pragma("unroll") for (int n = 0; n < 2; ++n) _Pragma("unroll") for (int k = 0; k < 2; ++k) dst[n][k] = *(const LAS bf16x8*)(lds + PG8_SB(b, h) + boff + n * 2048 + k * 1024); } while (0)
#define PG8_CAT(x) __builtin_shufflevector(__builtin_bit_cast(i32x4, x[0]), __builtin_bit_cast(i32x4, x[1]), 0, 1, 2, 3, 4, 5, 6, 7)
#define PG8_MMA(ai, bj, At, Bt) do { __builtin_amdgcn_s_setprio(1); _Pragma("unroll") for (int m = 0; m < 4; ++m) _Pragma("unroll") for (int n = 0; n < 2; ++n) { \
        if constexpr (FP8) mfma8(acc[ai][bj][m][n], PG8_CAT(Bt[n]), PG8_CAT(At[m]), sc_w, sc_a); \
        else { _Pragma("unroll") for (int k = 0; k < 2; ++k) acc[ai][bj][m][n] = __builtin_amdgcn_mfma_f32_16x16x32_bf16(Bt[n][k], At[m][k], acc[ai][bj][m][n], 0, 0, 0); } } __builtin_amdgcn_s_setprio(0); } while (0)
#define PG8_WAIT_V(n) asm volatile("s_waitcnt vmcnt(" #n ")" ::: "memory")
#define PG8_WAIT_L(n) asm volatile("s_waitcnt lgkmcnt(" #n ")" ::: "memory")
#define PG8_BAR __builtin_amdgcn_s_barrier()
#define PG8_SCHED __builtin_amdgcn_sched_barrier(0)
    Unit cur, nxt; int ui = 0;
    if (!S.next(0, cur)) return;
    if constexpr (GATHER) {
        int gv_[8];
#pragma unroll
        for (int i = 0; i < 8; ++i) { Unit uu; const bool ok = S.next(i, uu); gv_[i] = (ok && tid < 256) ? g.gidx[uu.pm * BM + tid] : 0; }
#pragma unroll
        for (int i = 0; i < 8; ++i) if (tid < 256) gl[i * 256 + tid] = gv_[i];
        __syncthreads();
#pragma unroll
        for (int h = 0; h < 2; ++h)
#pragma unroll
            for (int i = 0; i < 2; ++i) { vAc[h][i] = (unsigned)(gl[h * HALF + Rs[i]] * g.lda + Cs[i]) * 2u; vAn[h][i] = vAc[h][i]; }
    }
    f32x4 acc[2][2][4][2];
#pragma unroll
    for (int a = 0; a < 2; ++a)
#pragma unroll
        for (int b = 0; b < 2; ++b)
#pragma unroll
            for (int m = 0; m < 4; ++m)
#pragma unroll
                for (int n = 0; n < 2; ++n) acc[a][b][m][n] = (f32x4){0.f, 0.f, 0.f, 0.f};
    bf16x8 At[4][2], B0[2][2], B1[2][2];
    const char* cA = (const char*)g.A + (GATHER ? (size_t)0 : ((size_t)cur.pm * BM * g.lda + (size_t)cur.e * g.astride_e) * 2);
    const char* cB = (const char*)g.Bt + ((size_t)cur.e * g.bstride_e + (size_t)cur.pn * BM * g.ldb) * 2;
    PG8_STAGE(PG8_SB(0, 0), cB, voffB); PG8_STAGE(PG8_SB(0, 1), cB + hstepB, voffB); PG8_STAGE(PG8_SA(0, 0), cA, vAc[0]); PG8_STAGE(PG8_SA(0, 1), cA, vAc[1]);
    if (wr == 1) PG8_BAR;
    PG8_WAIT_V(2); PG8_BAR;
    PG8_STAGE(PG8_SB(1, 0), cB + kstep, voffB); PG8_STAGE(PG8_SA(1, 0), cA + kstep, vAc[0]); PG8_STAGE(PG8_SB(1, 1), cB + hstepB + kstep, voffB);
    PG8_WAIT_V(6); PG8_BAR;
    for (;;) {
        const bool has_next = S.next(ui + 1, nxt);
        const char* nA = has_next ? (const char*)g.A + (GATHER ? (size_t)0 : ((size_t)nxt.pm * BM * g.lda + (size_t)nxt.e * g.astride_e) * 2) : cA;
        const char* nB = has_next ? (const char*)g.Bt + ((size_t)nxt.e * g.bstride_e + (size_t)nxt.pn * BM * g.ldb) * 2 : cB;
        if constexpr (GATHER) { if (has_next) {
#pragma unroll
            for (int h = 0; h < 2; ++h)
#pragma unroll
                for (int i = 0; i < 2; ++i) vAn[h][i] = (unsigned)(gl[(ui + 1) * 256 + h * HALF + Rs[i]] * g.lda + Cs[i]) * 2u; } }
        for (int t = 0; t < nt; t += 2) {
            const bool last = (t == nt - 2);
            const char* a1 = cA + (size_t)(t + 1) * kstep;
            const char* a2 = last ? nA : cA + (size_t)(t + 2) * kstep; const char* b2 = last ? nB : cB + (size_t)(t + 2) * kstep;
            const char* a3 = a2 + kstep; const char* b3 = b2 + kstep;
            unsigned v2[2][2];
#pragma unroll
            for (int h = 0; h < 2; ++h)
#pragma unroll
                for (int i = 0; i < 2; ++i) v2[h][i] = GATHER ? (last ? vAn[h][i] : vAc[h][i]) : vAc[h][i];
            PG8_LDB(B0, 0, 0); PG8_LDB(B1, 0, 1); PG8_SCHED; PG8_LDA(At, 0, 0); PG8_STAGE(PG8_SA(1, 1), a1, vAc[1]);
            PG8_WAIT_V(8); PG8_WAIT_L(0); PG8_BAR; PG8_MMA(0, 0, At, B0); PG8_MMA(0, 1, At, B1); PG8_BAR; PG8_SCHED;
            PG8_LDA(At, 0, 1); PG8_STAGE(PG8_SB(0, 0), b2, voffB); PG8_STAGE(PG8_SB(0, 1), b2 + hstepB, voffB); PG8_STAGE(PG8_SA(0, 0), a2, v2[0]);
            PG8_WAIT_V(8); PG8_WAIT_L(0); PG8_BAR; PG8_MMA(1, 0, At, B0); PG8_MMA(1, 1, At, B1); PG8_BAR; PG8_SCHED;
            PG8_LDB(B0, 1, 0); PG8_LDB(B1, 1, 1); PG8_SCHED; PG8_LDA(At, 1, 0); PG8_STAGE(PG8_SA(0, 1), a2, v2[1]);
            PG8_WAIT_V(8); PG8_WAIT_L(0); PG8_BAR; PG8_MMA(0, 0, At, B0); PG8_MMA(0, 1, At, B1); PG8_BAR; PG8_SCHED;
            PG8_LDA(At, 1, 1); PG8_STAGE(PG8_SB(1, 0), b3, voffB); PG8_STAGE(PG8_SB(1, 1), b3 + hstepB, voffB); PG8_STAGE(PG8_SA(1, 0), a3, v2[0]);
            PG8_WAIT_V(8); PG8_WAIT_L(0); PG8_BAR; PG8_MMA(1, 0, At, B0); PG8_MMA(1, 1, At, B1); PG8_BAR; PG8_SCHED;
        }
        if constexpr (FP8) asm volatile("s_nop 15\n\ts_nop 15" ::: "memory");
        if (wr == 0) PG8_BAR;
        E(acc, cur, wr, wc, fr, fq);
        if (!has_next) break;
#pragma unroll
        for (int a = 0; a < 2; ++a)
#pragma unroll
            for (int b = 0; b < 2; ++b)
#pragma unroll
                for (int m = 0; m < 4; ++m)
#pragma unroll
                    for (int n = 0; n < 2; ++n) acc[a][b][m][n] = (f32x4){0.f, 0.f, 0.f, 0.f};
        cur = nxt; cA = nA; cB = nB; ++ui;
        if constexpr (GATHER) {
#pragma unroll
            for (int h = 0; h < 2; ++h)
#pragma unroll
                for (int i = 0; i < 2; ++i) vAc[h][i] = vAn[h][i]; }
        if (wr == 1) PG8_BAR;
    }
    PG8_WAIT_V(0);
    PG8_BAR;
#undef PG8_SA
#undef PG8_SB
#undef PG8_STAGE
#undef PG8_LDA
#undef PG8_LDB
#undef PG8_MMA
#undef PG8_CAT
#undef PG8_WAIT_V
#undef PG8_WAIT_L
#undef PG8_BAR
#undef PG8_SCHED
}
}
namespace att {
constexpr int KBUF = 12288, VBUF = 8192;
constexpr int TS = 1;
constexpr int L_K = 0, L_V = 2 * TS * KBUF, L_WS = L_V + 2 * TS * VBUF, L_OST = L_WS + NWAVES * 512, L_END = L_OST + NWAVES * 4096;
static_assert(L_END <= RING_BYTES, "attention scratch fits the ring region");
constexpr float THR = 8.f;
constexpr float NEGBIG = -1e30f;

__device__ __forceinline__ int crow(int r, int hi) { return (r & 3) + 8 * (r >> 2) + 4 * hi; }
__device__ __forceinline__ unsigned cvtpk(float lo, float hi) { typedef __bf16 bf16x2_t __attribute__((ext_vector_type(2))); f32x2 v = {lo, hi}; bf16x2_t b = __builtin_convertvector(v, bf16x2_t); return __builtin_bit_cast(unsigned, b); }
typedef short v4i16_t __attribute__((ext_vector_type(4)));
__device__ __forceinline__ s16x4 vtr(const LAS char* p) { return __builtin_bit_cast(s16x4, __builtin_amdgcn_ds_read_tr16_b64_v4i16((LAS v4i16_t*)p)); }

struct Desc {
    const bf16_t* Q; int qp, qo;
    const bf16_t* K; int kp, ko;
    const bf16_t* V; int vp, vo;
    bf16_t* O; int oo;
    int qmode; const float* tab; const float* gq;
};
template <int NMAP, int ND>
__device__ __forceinline__ void load_q(const Desc& D, size_t row, int t, int hq, int hi, bf16x8 (&qr)[NMAP][ND]) {
    constexpr int DKT = NMAP * ND * 16;
    const bf16_t* qrow = D.Q + row * D.qp + D.qo + hq * DKT + hi * 8;
#pragma unroll
    for (int m = 0; m < NMAP; ++m)
#pragma unroll
        for (int d0 = 0; d0 < ND; ++d0) qr[m][d0] = *(const bf16x8*)(qrow + m * ND * 16 + d0 * 16);
    if (D.qmode == 0) return;
    if constexpr ((NMAP == 1 && ND == 4) || (NMAP == 2 && ND == 2)) {
        constexpr int HP = ND / 2;
        const bool lat = t >= CTXL; const int p = lat ? t - CTXL : 0, py = p >> 6, px = p & 63;
        const float scale = (NMAP == 1 ? 0.125f : 0.17677669529663687f) * LOG2E;
#pragma unroll
        for (int m = 0; m < NMAP; ++m) {
            float x[ND][8];
#pragma unroll
            for (int d0 = 0; d0 < ND; ++d0)
#pragma unroll
                for (int j = 0; j < 8; ++j) x[d0][j] = bf2f((unsigned)(unsigned short)qr[m][d0][j]);
            if constexpr (NMAP == 1) { if (D.qmode == 2) {
                float ss = 0.f;
#pragma unroll
                for (int d0 = 0; d0 < ND; ++d0)
#pragma unroll
                    for (int j = 0; j < 8; ++j) ss += x[d0][j] * x[d0][j];
                { auto rr = __builtin_amdgcn_permlane32_swap(__float_as_uint(ss), __float_as_uint(ss), false, false); ss = __uint_as_float(rr[0]) + __uint_as_float(rr[1]); }
                const float rs = rsqrtf(ss * (1.f / 64.f) + EPS);
#pragma unroll
                for (int d0 = 0; d0 < ND; ++d0) { const f32x4 g0 = *(const f32x4*)(D.gq + d0 * 16 + hi * 8), g1 = *(const f32x4*)(D.gq + d0 * 16 + hi * 8 + 4);
#pragma unroll
                    for (int j = 0; j < 8; ++j) x[d0][j] *= rs * (j < 4 ? g0[j] : g1[j - 4]); } } }
            if (lat) {
#pragma unroll
                for (int d0 = 0; d0 < HP; ++d0) {
                    const float* tb = (NMAP == 1) ? D.tab + (((d0 == 0 ? py : px) * 16 + 8 * hi) * 2) : D.tab + (((hi == 0 ? py : px) * 8) * 2);
                    f32x4 tv[4];
#pragma unroll
                    for (int k = 0; k < 4; ++k) tv[k] = *(const f32x4*)(tb + 4 * k);
#pragma unroll
                    for (int j = 0; j < 8; ++j) { const float c = tv[j >> 1][(j & 1) * 2], sn = tv[j >> 1][(j & 1) * 2 + 1]; const float a = x[d0][j], b = x[d0 + HP][j];
                        x[d0][j] = a * c - b * sn; x[d0 + HP][j] = a * sn + b * c; } } }
#pragma unroll
            for (int d0 = 0; d0 < ND; ++d0)
#pragma unroll
                for (int j = 0; j < 8; ++j) qr[m][d0][j] = (short)f2bf(x[d0][j] * scale);
        }
    }
}

__device__ __forceinline__ float rowmax32(const f32x16& p0, const f32x16& p1) {
    float a = fmaxf(fmaxf(p0[0], p0[1]), p1[0]), b = fmaxf(fmaxf(p0[2], p0[3]), p1[1]); a = fmaxf(fmaxf(a, p1[2]), p1[3]);
#pragma unroll
    for (int r = 4; r < 16; r += 4) { a = fmaxf(fmaxf(a, p0[r]), p0[r + 1]); b = fmaxf(fmaxf(b, p0[r + 2]), p0[r + 3]); a = fmaxf(fmaxf(a, p1[r]), p1[r + 1]); b = fmaxf(fmaxf(b, p1[r + 2]), p1[r + 3]); }
    float m = fmaxf(a, b);
    auto rr = __builtin_amdgcn_permlane32_swap(__float_as_uint(m), __float_as_uint(m), false, false);
    return fmaxf(__uint_as_float(rr[0]), __uint_as_float(rr[1]));
}

template <int NMAP, int ND, bool AWIN, bool NOMAX = false>
__device__ __forceinline__ bool attn_unit(const Desc& D, int b, int hq, int hk, int hv, int qt0, int ntile, int wstart, bool win, float sink2,
                                          float lam, const float* subln, float omul, unsigned char* shm, bool dbg_noctx = false) {
    constexpr int TSL = (NMAP == 2) ? 1 : TS;
    constexpr int NCH = NMAP * ND * 2;
    constexpr int DKT = NMAP * ND * 16;
    int tid_ = threadIdx.x; asm volatile("" : "+v"(tid_));
    const int tid = tid_, lane = tid & 63, r32 = lane & 31, hi = lane >> 5; const int wid = __builtin_amdgcn_readfirstlane(tid >> 6);
    constexpr bool LMFMA = false;
    constexpr bool NEGM = (NMAP == 1) && !NOMAX;
    const size_t rowb = (size_t)b * RB;
    float* wsf0 = (float*)(shm + L_WS) + wid * 128;
    const bf16_t* ksrc0 = D.K + (rowb + (tid & 63)) * D.kp + D.ko + hk * DKT + (tid >> 6) * 8;
    const bf16_t* ksrc1 = ksrc0 + 64;
    const bf16_t* vsrc = D.V + (rowb + 16 * (wid & 3) + (lane >> 2)) * D.vp + D.vo + hv * 64 + (wid >> 2) * 32 + (lane & 3) * 8;
    const bool k1on = (NCH > 8) && (tid < (NCH - 8) * 64);
    bf16x8 qr[NMAP][ND];
    float mhat[NMAP], lreg[NMAP]; f32x16 o[NMAP][2], negm[NEGM ? NMAP : 1], ol[LMFMA ? NMAP : 1];
    if constexpr (LMFMA) {
#pragma unroll
        for (int m = 0; m < NMAP; ++m) ol[m] = f32x16{}; }
    const bf16x8 ones8 = {0x3F80, 0x3F80, 0x3F80, 0x3F80, 0x3F80, 0x3F80, 0x3F80, 0x3F80};
#pragma unroll
    for (int m = 0; m < NMAP; ++m) { mhat[m] = 0.f; lreg[m] = 0.f; o[m][0] = f32x16{}; o[m][1] = f32x16{}; if (NEGM) negm[m] = f32x16{}; }
    const int qt = qt0 + wid * 32 + r32;
    const int vlane = ((lane >> 4) & 1) * 32 + (lane & 3) * 8 + (4 * hi + ((lane & 15) >> 2)) * 64;
    u32x4 kr0[TSL], kr1[TSL], vr[TSL];
#pragma unroll
    for (int q = 0; q < TSL; ++q) kr1[q] = u32x4{};
#define ATT_TILE(j) (dbg_noctx ? (wstart + (j)) : ((j) < 4 ? (j) : wstart + (j) - 4))
#define ATT_LOAD(st) do { _Pragma("unroll") for (int q_ = 0; q_ < TSL; ++q_) { const size_t ro_ = (size_t)ATT_TILE((st) * TSL + q_) * 64; kr0[q_] = *(const u32x4*)(ksrc0 + ro_ * D.kp); if (k1on) kr1[q_] = *(const u32x4*)(ksrc1 + ro_ * D.kp); vr[q_] = *(const u32x4*)(vsrc + ro_ * D.vp); } } while (0)
#define ATT_WRITE(buf) do { _Pragma("unroll") for (int q_ = 0; q_ < TSL; ++q_) { *(u32x4*)(shm + L_K + ((buf) * TSL + q_) * KBUF + tid * 16) = kr0[q_]; if (k1on) *(u32x4*)(shm + L_K + ((buf) * TSL + q_) * KBUF + 8192 + tid * 16) = kr1[q_]; *(u32x4*)(shm + L_V + ((buf) * TSL + q_) * VBUF + tid * 16) = vr[q_]; } } while (0)
    const int nstage = ntile / TSL;
    ATT_LOAD(0);
    load_q<NMAP, ND>(D, rowb + qt0 + wid * 32 + r32, qt0 + wid * 32 + r32, hq, hi, qr);
    ATT_WRITE(0);
    __syncthreads();
    if (nstage > 1) ATT_LOAD(1);
    for (int st = 0; st < nstage; ++st) {
        const int cur = st & 1;
#pragma unroll
      for (int q = 0; q < TSL; ++q) { const int j = st * TSL + q;
        const unsigned char* kb = shm + L_K + (cur * TSL + q) * KBUF;
        const LAS char* vb = (const LAS char*)(shm + L_V + (cur * TSL + q) * VBUF) + vlane;
        s16x4 vlo[8], vhi[8];
#pragma unroll
        for (int i = 0; i < 8; ++i) { vlo[i] = vtr(vb + (i >> 2) * 4096 + (i & 3) * 1024); vhi[i] = vtr(vb + (i >> 2) * 4096 + (i & 3) * 1024 + 512); }
        if constexpr (NMAP == 2 && NOMAX) {
            f32x16 sc[2][2]; bf16x8 kfr[2][ND][2];
#pragma unroll
            for (int m = 0; m < 2; ++m)
#pragma unroll
                for (int d0 = 0; d0 < ND; ++d0) { kfr[m][d0][0] = *(const bf16x8*)(kb + ((m * ND + d0) * 2 + hi) * 1024 + r32 * 16); kfr[m][d0][1] = *(const bf16x8*)(kb + ((m * ND + d0) * 2 + hi) * 1024 + 512 + r32 * 16); }
#pragma unroll
            for (int m = 0; m < 2; ++m) { sc[m][0] = f32x16{}; sc[m][1] = f32x16{};
#pragma unroll
                for (int d0 = 0; d0 < ND; ++d0) { sc[m][0] = __builtin_amdgcn_mfma_f32_32x32x16_bf16(kfr[m][d0][0], qr[m][d0], sc[m][0], 0, 0, 0); sc[m][1] = __builtin_amdgcn_mfma_f32_32x32x16_bf16(kfr[m][d0][1], qr[m][d0], sc[m][1], 0, 0, 0); } }
            u32x4 pwa[4], pwb[4]; float sa = 0.f, sb = 0.f;
#pragma unroll
            for (int r = 0; r < 16; ++r) { sc[0][0][r] = __builtin_amdgcn_exp2f(sc[0][0][r]); sc[0][1][r] = __builtin_amdgcn_exp2f(sc[0][1][r]); sa += sc[0][0][r] + sc[0][1][r]; }
#pragma unroll
            for (int q = 0; q < 2; ++q) {
                pwa[q]     = (u32x4){cvtpk(sc[0][0][8 * q], sc[0][0][8 * q + 1]), cvtpk(sc[0][0][8 * q + 2], sc[0][0][8 * q + 3]), cvtpk(sc[0][0][8 * q + 4], sc[0][0][8 * q + 5]), cvtpk(sc[0][0][8 * q + 6], sc[0][0][8 * q + 7])};
                pwa[2 + q] = (u32x4){cvtpk(sc[0][1][8 * q], sc[0][1][8 * q + 1]), cvtpk(sc[0][1][8 * q + 2], sc[0][1][8 * q + 3]), cvtpk(sc[0][1][8 * q + 4], sc[0][1][8 * q + 5]), cvtpk(sc[0][1][8 * q + 6], sc[0][1][8 * q + 7])}; }
#pragma unroll
            for (int ks = 0; ks < 4; ++ks) {
#pragma unroll
                for (int d0 = 0; d0 < 2; ++d0) {
                    const bf16x8 vf = (bf16x8){vlo[d0 * 4 + ks][0], vlo[d0 * 4 + ks][1], vlo[d0 * 4 + ks][2], vlo[d0 * 4 + ks][3], vhi[d0 * 4 + ks][0], vhi[d0 * 4 + ks][1], vhi[d0 * 4 + ks][2], vhi[d0 * 4 + ks][3]};
                    o[0][d0] = __builtin_amdgcn_mfma_f32_32x32x16_bf16(__builtin_bit_cast(bf16x8, pwa[ks]), vf, o[0][d0], 0, 0, 0); }
                { const int hf = ks >> 1, q = ks & 1;
#pragma unroll
                  for (int r = 8 * q; r < 8 * q + 8; ++r) { sc[1][hf][r] = __builtin_amdgcn_exp2f(sc[1][hf][r]); sb += sc[1][hf][r]; }
                  pwb[2 * hf + q] = (u32x4){cvtpk(sc[1][hf][8 * q], sc[1][hf][8 * q + 1]), cvtpk(sc[1][hf][8 * q + 2], sc[1][hf][8 * q + 3]), cvtpk(sc[1][hf][8 * q + 4], sc[1][hf][8 * q + 5]), cvtpk(sc[1][hf][8 * q + 6], sc[1][hf][8 * q + 7])}; }
            }
#pragma unroll
            for (int ks = 0; ks < 4; ++ks)
#pragma unroll
                for (int d0 = 0; d0 < 2; ++d0) {
                    const bf16x8 vf = (bf16x8){vlo[d0 * 4 + ks][0], vlo[d0 * 4 + ks][1], vlo[d0 * 4 + ks][2], vlo[d0 * 4 + ks][3], vhi[d0 * 4 + ks][0], vhi[d0 * 4 + ks][1], vhi[d0 * 4 + ks][2], vhi[d0 * 4 + ks][3]};
                    o[1][d0] = __builtin_amdgcn_mfma_f32_32x32x16_bf16(__builtin_bit_cast(bf16x8, pwb[ks]), vf, o[1][d0], 0, 0, 0); }
            lreg[0] += sa; lreg[1] += sb;
        } else
#pragma unroll
        for (int m = 0; m < NMAP; ++m) {
            f32x16 p0, p1; if constexpr (NEGM) { p0 = negm[m]; p1 = negm[m]; } else { p0 = f32x16{}; p1 = f32x16{}; }
            bf16x8 kfr[ND][2];
#pragma unroll
            for (int d0 = 0; d0 < ND; ++d0) { kfr[d0][0] = *(const bf16x8*)(kb + ((m * ND + d0) * 2 + hi) * 1024 + r32 * 16); kfr[d0][1] = *(const bf16x8*)(kb + ((m * ND + d0) * 2 + hi) * 1024 + 512 + r32 * 16); }
#pragma unroll
            for (int d0 = 0; d0 < ND; ++d0) {
                p0 = __builtin_amdgcn_mfma_f32_32x32x16_bf16(kfr[d0][0], qr[m][d0], p0, 0, 0, 0);
                p1 = __builtin_amdgcn_mfma_f32_32x32x16_bf16(kfr[d0][1], qr[m][d0], p1, 0, 0, 0);
            }
            if constexpr (AWIN) { if (win && (dbg_noctx || j >= 4)) {
                const int kt0 = ATT_TILE(j) * 64 + 4 * hi - qt;
#pragma unroll
                for (int r = 0; r < 16; ++r) { const int dd = kt0 + (r & 3) + 8 * (r >> 2); if (dd < -128 || dd > 128) p0[r] = NEGBIG; if (dd + 32 < -128 || dd + 32 > 128) p1[r] = NEGBIG; } } }
            float rm = 0.f;
            if constexpr (!NOMAX) { rm = rowmax32(p0, p1); if constexpr (!NEGM) rm -= mhat[m]; }
            if (!NOMAX && (j == 0 || __any(rm > THR))) {
                const float dl = (j == 0) ? rm : fmaxf(rm, 0.f);
                mhat[m] += dl;
                if constexpr (NEGM) {
#pragma unroll
                    for (int r = 0; r < 16; ++r) { p0[r] -= dl; p1[r] -= dl; }
#pragma unroll
                    for (int r = 0; r < 16; ++r) negm[m][r] = -mhat[m];
                }
                if (j > 0) { float* wsf = wsf0 + m * 64; const float f = __builtin_amdgcn_exp2f(-dl); lreg[m] *= f; if (hi == 0) wsf[r32] = f;
                    LDS_WAIT();
#pragma unroll
                    for (int d_ = 0; d_ < 2; ++d_)
#pragma unroll
                        for (int r = 0; r < 16; ++r) o[m][d_][r] *= wsf[crow(r, hi)];
                    LDS_WAIT(); }
            }
            float sacc = 0.f;
#pragma unroll
            for (int r = 0; r < 16; ++r) { if constexpr (!NEGM && !NOMAX) { p0[r] -= mhat[m]; p1[r] -= mhat[m]; } p0[r] = __builtin_amdgcn_exp2f(p0[r]); p1[r] = __builtin_amdgcn_exp2f(p1[r]); if constexpr (!LMFMA) sacc += p0[r] + p1[r]; }
            lreg[m] += sacc;
            u32x4 pw[4];
#pragma unroll
            for (int s = 0; s < 2; ++s) {
                pw[s]     = (u32x4){cvtpk(p0[8 * s], p0[8 * s + 1]), cvtpk(p0[8 * s + 2], p0[8 * s + 3]), cvtpk(p0[8 * s + 4], p0[8 * s + 5]), cvtpk(p0[8 * s + 6], p0[8 * s + 7])};
                pw[2 + s] = (u32x4){cvtpk(p1[8 * s], p1[8 * s + 1]), cvtpk(p1[8 * s + 2], p1[8 * s + 3]), cvtpk(p1[8 * s + 4], p1[8 * s + 5]), cvtpk(p1[8 * s + 6], p1[8 * s + 7])};
            }
#pragma unroll
            for (int d0 = 0; d0 < 2; ++d0)
#pragma unroll
                for (int ks = 0; ks < 4; ++ks) {
                    const bf16x8 vf = (bf16x8){vlo[d0 * 4 + ks][0], vlo[d0 * 4 + ks][1], vlo[d0 * 4 + ks][2], vlo[d0 * 4 + ks][3], vhi[d0 * 4 + ks][0], vhi[d0 * 4 + ks][1], vhi[d0 * 4 + ks][2], vhi[d0 * 4 + ks][3]};
                    o[m][d0] = __builtin_amdgcn_mfma_f32_32x32x16_bf16(__builtin_bit_cast(bf16x8, pw[ks]), vf, o[m][d0], 0, 0, 0);
                }
            if constexpr (LMFMA) {
#pragma unroll
                for (int ks = 0; ks < 4; ++ks) ol[m] = __builtin_amdgcn_mfma_f32_32x32x16_bf16(__builtin_bit_cast(bf16x8, pw[ks]), ones8, ol[m], 0, 0, 0); }
        }
      }
        if (st + 1 < nstage) ATT_WRITE(cur ^ 1);
        __syncthreads();
        if (st + 2 < nstage) ATT_LOAD(st + 2);
    }
#undef ATT_TILE
#undef ATT_LOAD
#undef ATT_WRITE
    float rli[NMAP][16]; float lfin[NMAP];
    if constexpr (LMFMA) {
        bool bad = false;
#pragma unroll
        for (int m = 0; m < NMAP; ++m)
#pragma unroll
            for (int r = 0; r < 16; ++r) { const float l = ol[m][r]; bad = bad || !(l > 1e-30f && l < 1e30f); rli[m][r] = 1.f / l; }
        if (__syncthreads_or(bad ? 1 : 0)) return true;
    } else {
#pragma unroll
    for (int m = 0; m < NMAP; ++m) {
        float l = lreg[m];
        { auto rr = __builtin_amdgcn_permlane32_swap(__float_as_uint(l), __float_as_uint(l), false, false); l = __uint_as_float(rr[0]) + __uint_as_float(rr[1]); }
        if constexpr (AWIN) l += __builtin_amdgcn_exp2f(sink2 - mhat[m]);
        lfin[m] = l; }
    if constexpr (NOMAX) { bool bad = false;
#pragma unroll
        for (int m = 0; m < NMAP; ++m) bad = bad || !(lfin[m] > 1e-30f && lfin[m] < 1e30f);
        if (__syncthreads_or(bad ? 1 : 0)) return true; }
#pragma unroll
    for (int m = 0; m < NMAP; ++m) {
        const float l = lfin[m];
        float* wsf = wsf0 + m * 64;
        if (hi == 0) wsf[32 + r32] = 1.f / l;
        LDS_WAIT();
#pragma unroll
        for (int r = 0; r < 16; ++r) rli[m][r] = wsf[32 + crow(r, hi)];
        LDS_WAIT();
    }
    }
    bf16_t* stg = (bf16_t*)(shm + L_OST) + wid * 2048;
    if constexpr (NMAP == 2) {
        const float g0 = subln[r32] * omul, g1 = subln[32 + r32] * omul;
#pragma unroll
        for (int r = 0; r < 16; ++r) {
            const float d0v = o[0][0][r] * rli[0][r] - lam * (o[1][0][r] * rli[1][r]);
            const float d1v = o[0][1][r] * rli[0][r] - lam * (o[1][1][r] * rli[1][r]);
            const float ss = half_sum(d0v * d0v + d1v * d1v, lane);
            const float rs = rsqrtf(ss * (1.f / 64.f) + EPS);
            const int orow = crow(r, hi);
            stg[orow * 64 + r32] = (bf16_t)f2bf(d0v * rs * g0); stg[orow * 64 + 32 + r32] = (bf16_t)f2bf(d1v * rs * g1);
        }
    } else {
#pragma unroll
        for (int r = 0; r < 16; ++r) { const int orow = crow(r, hi);
            stg[orow * 64 + r32] = (bf16_t)f2bf(o[0][0][r] * rli[0][r] * omul); stg[orow * 64 + 32 + r32] = (bf16_t)f2bf(o[0][1][r] * rli[0][r] * omul); }
    }
    bf16_t* Ow = D.O + (rowb + qt0 + wid * 32) * DM + D.oo + hq * 64;
#pragma unroll
    for (int i = 0; i < 4; ++i) { const int row = i * 8 + (lane >> 3), ch = lane & 7; const u32x4 v = *(const u32x4*)(stg + row * 64 + ch * 8); *(u32x4*)(Ow + (size_t)row * DM + ch * 8) = v; }
    __syncthreads();
    return false;
}

template <int V> struct IC { static constexpr int value = V; };
template <int NMAP, int ND, bool AWIN, bool NOMAX = false>
__device__ __forceinline__ bool attn_unit_d(const Desc& D, int b, int hq, int hk, int hv, int qt0, int ntile, int wstart, bool win, float sink2,
                                          float lam, const float* subln, float omul, unsigned char* shm, bool dbg_noctx = false) {
    constexpr int TSL = (NMAP == 2) ? 1 : TS;
    constexpr int NCH = NMAP * ND * 2;
    constexpr int DKT = NMAP * ND * 16;
    int tid_ = threadIdx.x; asm volatile("" : "+v"(tid_));
    const int tid = tid_, lane = tid & 63, r32 = lane & 31, hi = lane >> 5; const int wid = __builtin_amdgcn_readfirstlane(tid >> 6);
    constexpr bool LMFMA = false;
    constexpr bool NEGM = (NMAP == 1) && !NOMAX;
    const size_t rowb = (size_t)b * RB;
    float* wsf0 = (float*)(shm + L_WS) + wid * 128;
    const bf16_t* ksrc0 = D.K + (rowb + (tid & 63)) * D.kp + D.ko + hk * DKT + (tid >> 6) * 8;
    const bf16_t* ksrc1 = ksrc0 + 64;
    const bf16_t* vsrc = D.V + (rowb + 16 * (wid & 3) + (lane >> 2)) * D.vp + D.vo + hv * 64 + (wid >> 2) * 32 + (lane & 3) * 8;
    const bool k1on = (NCH > 8) && (tid < (NCH - 8) * 64);
    bf16x8 qr[NMAP][ND];
    float mhat[NMAP], lreg[NMAP]; f32x16 o[NMAP][2], negm[NEGM ? NMAP : 1], ol[LMFMA ? NMAP : 1];
    if constexpr (LMFMA) {
#pragma unroll
        for (int m = 0; m < NMAP; ++m) ol[m] = f32x16{}; }
    const bf16x8 ones8 = {0x3F80, 0x3F80, 0x3F80, 0x3F80, 0x3F80, 0x3F80, 0x3F80, 0x3F80};
#pragma unroll
    for (int m = 0; m < NMAP; ++m) { mhat[m] = 0.f; lreg[m] = 0.f; o[m][0] = f32x16{}; o[m][1] = f32x16{}; if (NEGM) negm[m] = f32x16{}; }
    const int qt = qt0 + wid * 32 + r32;
    const int vlane = ((lane >> 4) & 1) * 32 + (lane & 3) * 8 + (4 * hi + ((lane & 15) >> 2)) * 64;
    u32x4 kr0[2], kr1[2], vr[2];
#pragma unroll
    for (int q = 0; q < 2; ++q) kr1[q] = u32x4{};
#define ATT_TILE(j) (dbg_noctx ? (wstart + (j)) : ((j) < 4 ? (j) : wstart + (j) - 4))
#define ATT_LOAD(j, S) do { const size_t ro_ = (size_t)ATT_TILE(j) * 64; kr0[S] = *(const u32x4*)(ksrc0 + ro_ * D.kp); if (k1on) kr1[S] = *(const u32x4*)(ksrc1 + ro_ * D.kp); vr[S] = *(const u32x4*)(vsrc + ro_ * D.vp); } while (0)
#define ATT_WRITE(buf, S) do { *(u32x4*)(shm + L_K + (buf) * KBUF + tid * 16) = kr0[S]; if (k1on) *(u32x4*)(shm + L_K + (buf) * KBUF + 8192 + tid * 16) = kr1[S]; *(u32x4*)(shm + L_V + (buf) * VBUF + tid * 16) = vr[S]; } while (0)
#define ATT_BAR() do { asm volatile("s_waitcnt lgkmcnt(0)" ::: "memory"); __builtin_amdgcn_s_barrier(); asm volatile("" ::: "memory"); } while (0)
    constexpr bool DEEP = (NMAP == 1);
    ATT_LOAD(0, 0);
    load_q<NMAP, ND>(D, rowb + qt0 + wid * 32 + r32, qt0 + wid * 32 + r32, hq, hi, qr);
    ATT_WRITE(0, 0);
    ATT_BAR();
    if constexpr (DEEP) { if (ntile > 1) ATT_LOAD(1, 1); if (ntile > 2) ATT_LOAD(2, 0); } else { if (ntile > 1) ATT_LOAD(1, 0); }
    auto do_tile = [&](const int j, const int cur, auto setc) __attribute__((always_inline)) {
        constexpr int WSET = DEEP ? (decltype(setc)::value ^ 1) : 0;
        const unsigned char* kb = shm + L_K + cur * KBUF;
        const LAS char* vb = (const LAS char*)(shm + L_V + cur * VBUF) + vlane;
        s16x4 vlo[8], vhi[8];
#pragma unroll
        for (int i = 0; i < 8; ++i) { vlo[i] = vtr(vb + (i >> 2) * 4096 + (i & 3) * 1024); vhi[i] = vtr(vb + (i >> 2) * 4096 + (i & 3) * 1024 + 512); }
#pragma unroll
        for (int m = 0; m < NMAP; ++m) {
            f32x16 p0, p1; if constexpr (NEGM) { p0 = negm[m]; p1 = negm[m]; } else { p0 = f32x16{}; p1 = f32x16{}; }
            bf16x8 kfr[ND][2];
#pragma unroll
            for (int d0 = 0; d0 < ND; ++d0) { kfr[d0][0] = *(const bf16x8*)(kb + ((m * ND + d0) * 2 + hi) * 1024 + r32 * 16); kfr[d0][1] = *(const bf16x8*)(kb + ((m * ND + d0) * 2 + hi) * 1024 + 512 + r32 * 16); }
#pragma unroll
            for (int d0 = 0; d0 < ND; ++d0) {
                p0 = __builtin_amdgcn_mfma_f32_32x32x16_bf16(kfr[d0][0], qr[m][d0], p0, 0, 0, 0);
                p1 = __builtin_amdgcn_mfma_f32_32x32x16_bf16(kfr[d0][1], qr[m][d0], p1, 0, 0, 0);
            }
            if constexpr (AWIN) { if (win && (dbg_noctx || j >= 4)) {
                const int kt0 = ATT_TILE(j) * 64 + 4 * hi - qt;
#pragma unroll
                for (int r = 0; r < 16; ++r) { const int dd = kt0 + (r & 3) + 8 * (r >> 2); if (dd < -128 || dd > 128) p0[r] = NEGBIG; if (dd + 32 < -128 || dd + 32 > 128) p1[r] = NEGBIG; } } }
            float rm = 0.f;
            if constexpr (!NOMAX) { rm = rowmax32(p0, p1); if constexpr (!NEGM) rm -= mhat[m]; }
            if (!NOMAX && (j == 0 || __any(rm > THR))) {
                const float dl = (j == 0) ? rm : fmaxf(rm, 0.f);
                mhat[m] += dl;
                if constexpr (NEGM) {
#pragma unroll
                    for (int r = 0; r < 16; ++r) { p0[r] -= dl; p1[r] -= dl; }
#pragma unroll
                    for (int r = 0; r < 16; ++r) negm[m][r] = -mhat[m];
                }
                if (j > 0) { float* wsf = wsf0 + m * 64; const float f = __builtin_amdgcn_exp2f(-dl); lreg[m] *= f; if (hi == 0) wsf[r32] = f;
                    LDS_WAIT();
#pragma unroll
                    for (int d_ = 0; d_ < 2; ++d_)
#pragma unroll
                        for (int r = 0; r < 16; ++r) o[m][d_][r] *= wsf[crow(r, hi)];
                    LDS_WAIT(); }
            }
            float sacc = 0.f;
#pragma unroll
            for (int r = 0; r < 16; ++r) { if constexpr (!NEGM && !NOMAX) { p0[r] -= mhat[m]; p1[r] -= mhat[m]; } p0[r] = __builtin_amdgcn_exp2f(p0[r]); p1[r] = __builtin_amdgcn_exp2f(p1[r]); if constexpr (!LMFMA) sacc += p0[r] + p1[r]; }
            lreg[m] += sacc;
            u32x4 pw[4];
#pragma unroll
            for (int s = 0; s < 2; ++s) {
                pw[s]     = (u32x4){cvtpk(p0[8 * s], p0[8 * s + 1]), cvtpk(p0[8 * s + 2], p0[8 * s + 3]), cvtpk(p0[8 * s + 4], p0[8 * s + 5]), cvtpk(p0[8 * s + 6], p0[8 * s + 7])};
                pw[2 + s] = (u32x4){cvtpk(p1[8 * s], p1[8 * s + 1]), cvtpk(p1[8 * s + 2], p1[8 * s + 3]), cvtpk(p1[8 * s + 4], p1[8 * s + 5]), cvtpk(p1[8 * s + 6], p1[8 * s + 7])};
            }
#pragma unroll
            for (int d0 = 0; d0 < 2; ++d0)
#pragma unroll
                for (int ks = 0; ks < 4; ++ks) {
                    const bf16x8 vf = (bf16x8){vlo[d0 * 4 + ks][0], vlo[d0 * 4 + ks][1], vlo[d0 * 4 + ks][2], vlo[d0 * 4 + ks][3], vhi[d0 * 4 + ks][0], vhi[d0 * 4 + ks][1], vhi[d0 * 4 + ks][2], vhi[d0 * 4 + ks][3]};
                    o[m][d0] = __builtin_amdgcn_mfma_f32_32x32x16_bf16(__builtin_bit_cast(bf16x8, pw[ks]), vf, o[m][d0], 0, 0, 0);
                }
            if constexpr (LMFMA) {
#pragma unroll
                for (int ks = 0; ks < 4; ++ks) ol[m] = __builtin_amdgcn_mfma_f32_32x32x16_bf16(__builtin_bit_cast(bf16x8, pw[ks]), ones8, ol[m], 0, 0, 0); }
        }
        if (j + 1 < ntile) ATT_WRITE(cur ^ 1, WSET);
        ATT_BAR();
        if constexpr (DEEP) { if (j + 3 < ntile) ATT_LOAD(j + 3, WSET); } else { if (j + 2 < ntile) ATT_LOAD(j + 2, 0); }
    };
    if constexpr (DEEP) { for (int j = 0; j < ntile; j += 2) { do_tile(j, 0, IC<0>{}); do_tile(j + 1, 1, IC<1>{}); } }
    else { for (int j = 0; j < ntile; ++j) do_tile(j, j & 1, IC<0>{}); }
#undef ATT_TILE
#undef ATT_LOAD
#undef ATT_WRITE
#undef ATT_BAR
    float rli[NMAP][16]; float lfin[NMAP];
    if constexpr (LMFMA) {
        bool bad = false;
#pragma unroll
        for (int m = 0; m < NMAP; ++m)
#pragma unroll
            for (int r = 0; r < 16; ++r) { const float l = ol[m][r]; bad = bad || !(l > 1e-30f && l < 1e30f); rli[m][r] = 1.f / l; }
        if (__syncthreads_or(bad ? 1 : 0)) return true;
    } else {
#pragma unroll
    for (int m = 0; m < NMAP; ++m) {
        float l = lreg[m];
        { auto rr = __builtin_amdgcn_permlane32_swap(__float_as_uint(l), __float_as_uint(l), false, false); l = __uint_as_float(rr[0]) + __uint_as_float(rr[1]); }
        if constexpr (AWIN) l += __builtin_amdgcn_exp2f(sink2 - mhat[m]);
        lfin[m] = l; }
    if constexpr (NOMAX) { bool bad = false;
#pragma unroll
        for (int m = 0; m < NMAP; ++m) bad = bad || !(lfin[m] > 1e-30f && lfin[m] < 1e30f);
        if (__syncthreads_or(bad ? 1 : 0)) return true; }
#pragma unroll
    for (int m = 0; m < NMAP; ++m) {
        const float l = lfin[m];
        float* wsf = wsf0 + m * 64;
        if (hi == 0) wsf[32 + r32] = 1.f / l;
        LDS_WAIT();
#pragma unroll
        for (int r = 0; r < 16; ++r) rli[m][r] = wsf[32 + crow(r, hi)];
        LDS_WAIT();
    }
    }
    bf16_t* stg = (bf16_t*)(shm + L_OST) + wid * 2048;
    if constexpr (NMAP == 2) {
        const float g0 = subln[r32] * omul, g1 = subln[32 + r32] * omul;
#pragma unroll
        for (int r = 0; r < 16; ++r) {
            const float d0v = o[0][0][r] * rli[0][r] - lam * (o[1][0][r] * rli[1][r]);
            const float d1v = o[0][1][r] * rli[0][r] - lam * (o[1][1][r] * rli[1][r]);
            const float ss = half_sum(d0v * d0v + d1v * d1v, lane);
            const float rs = rsqrtf(ss * (1.f / 64.f) + EPS);
            const int orow = crow(r, hi);
            stg[orow * 64 + r32] = (bf16_t)f2bf(d0v * rs * g0); stg[orow * 64 + 32 + r32] = (bf16_t)f2bf(d1v * rs * g1);
        }
    } else {
#pragma unroll
        for (int r = 0; r < 16; ++r) { const int orow = crow(r, hi);
            stg[orow * 64 + r32] = (bf16_t)f2bf(o[0][0][r] * rli[0][r] * omul); stg[orow * 64 + 32 + r32] = (bf16_t)f2bf(o[0][1][r] * rli[0][r] * omul); }
    }
    bf16_t* Ow = D.O + (rowb + qt0 + wid * 32) * DM + D.oo + hq * 64;
#pragma unroll
    for (int i = 0; i < 4; ++i) { const int row = i * 8 + (lane >> 3), ch = lane & 7; const u32x4 v = *(const u32x4*)(stg + row * 64 + ch * 8); *(u32x4*)(Ow + (size_t)row * DM + ch * 8) = v; }
    __syncthreads();
    return false;
}

}
typedef const __attribute__((address_space(4))) unsigned char* kaptr_t;
struct Args { kaptr_t ka; float* out; unsigned char* ws; int lo, hi; };
enum { I_X = 0, I_C, I_CTX, I_CCTX, I_WMOD, I_BMOD, I_GATTN, I_GFFN, I_WIN, I_ASINK, I_BQN, I_BWUQ, I_BKVN, I_BWUKV, I_CLAM, I_CSUBLN, I_DQN, I_DKN, I_WOUT, I_WROUTER,
       I_WGATE, I_WUP, I_WDOWN, I_GFINAL };

__device__ __forceinline__ const float* arg_in(const Args& a, int i) { const GAS float* p = *(const GAS float* const __attribute__((address_space(4)))*)(a.ka + 8 * i); return (const float*)p; }
struct TI { int tid, lane, wave, gw, ngw, gtid, ngt; };
__device__ __forceinline__ TI mk_ti() {
    int t = threadIdx.x; asm volatile("" : "+v"(t));
    TI r; r.tid = t; r.lane = t & 63; r.wave = __builtin_amdgcn_readfirstlane(t >> 6);
    r.gw = blockIdx.x * NWAVES + r.wave; r.ngw = gridDim.x * NWAVES; r.gtid = blockIdx.x * NTHREADS + t; r.ngt = gridDim.x * NTHREADS; return r;
}

#define XB_TMO      128
#define XB_XCNT(j)  (256  + 64 * (j))
#define XB_XSUB(j)  (1280 + 64 * (j))
#define XB_XGEN(j)  (2304 + 64 * (j))
#define XB_TOP      3328
#define XB_TOPGEN   3392
#define XCD_BAR_WORDS 3456
#define XB_SPIN_CAP (1u << 20)
__device__ __forceinline__ unsigned xb_ld(unsigned* p)              { return __hip_atomic_load(p, __ATOMIC_RELAXED, __HIP_MEMORY_SCOPE_AGENT); }
__device__ __forceinline__ unsigned xb_add(unsigned* p, unsigned v) { return __hip_atomic_fetch_add(p, v, __ATOMIC_RELAXED, __HIP_MEMORY_SCOPE_AGENT); }
__device__ __forceinline__ unsigned xb_xcc_id() { return (unsigned)__builtin_amdgcn_s_getreg((3 << 11) | 20) & 0xFu; }
#define XB_SPIN(cond, bar) do { unsigned _sp = 0; while (cond) { __builtin_amdgcn_s_sleep(1); \
    if ((++_sp & 255u) == 0u) { if (xb_ld(&(bar)[XB_TMO])) break; if (_sp > XB_SPIN_CAP) { atomicAdd(&(bar)[XB_TMO], 1u); break; } } } } while (0)
struct XcdBarrier { unsigned* bar; unsigned x; volatile LAS unsigned* st; };
__device__ __forceinline__ XcdBarrier xcd_barrier_post(unsigned* bar, volatile LAS unsigned* st) {
    XcdBarrier b; b.bar = bar; b.x = xb_xcc_id(); b.st = st;
    if (threadIdx.x == 0) (void)xb_add(&bar[XB_XCNT(b.x)], 1u);
    return b;
}
__device__ __forceinline__ void xcd_barrier_complete(unsigned* bar, unsigned x, unsigned& nloc, unsigned& nx) {
    const unsigned G = gridDim.x * gridDim.y * gridDim.z;
    unsigned sum, cnt, mine, sp = 0u;
    for (;;) {
        sum = 0u; cnt = 0u; mine = 0u;
#pragma unroll
        for (unsigned j = 0; j < 16; ++j) { const unsigned c = xb_ld(&bar[XB_XCNT(j)]); sum += c; cnt += (c > 0u) ? 1u : 0u; mine = (j == x) ? c : mine; }
        if (sum == G) break;
        __builtin_amdgcn_s_sleep(1);
        if ((++sp & 255u) == 0u) { if (xb_ld(&bar[XB_TMO])) break; if (sp > XB_SPIN_CAP) { atomicAdd(&bar[XB_TMO], 1u); break; } }
    }
    nloc = mine > 0u ? mine : 1u; nx = cnt > 0u ? cnt : 1u;
}
__device__ __forceinline__ void xcd_barrier(const XcdBarrier& b) {
    asm volatile("s_waitcnt vmcnt(0)" ::: "memory");
    __syncthreads();
    if (threadIdx.x == 0) {
        unsigned* bar = b.bar;
        __builtin_amdgcn_s_waitcnt(0);
        unsigned nloc = b.st[0], nx = b.st[1];
        if (nloc == 0u) { xcd_barrier_complete(bar, b.x, nloc, nx); b.st[0] = nloc; b.st[1] = nx; }
        const unsigned old = xb_add(&bar[XB_XSUB(b.x)], 1u);
        const unsigned gen = old / nloc;
        if (old + 1u == (gen + 1u) * nloc) {
            __builtin_amdgcn_fence(__ATOMIC_RELEASE, "agent");
            asm volatile("s_waitcnt vmcnt(0)" ::: "memory");
            const unsigned og = xb_add(&bar[XB_TOP], 1u);
            const unsigned tg = og / nx;
            if (og + 1u == (tg + 1u) * nx) xb_add(&bar[XB_TOPGEN], 1u);
            else XB_SPIN(xb_ld(&bar[XB_TOPGEN]) == tg, bar);
            __builtin_amdgcn_fence(__ATOMIC_ACQUIRE, "agent");
            xb_add(&bar[XB_XGEN(b.x)], 1u);
            asm volatile("s_waitcnt vmcnt(0)" ::: "memory");
        } else {
            XB_SPIN(xb_ld(&bar[XB_XGEN(b.x)]) == gen, bar);
            __builtin_amdgcn_fence(__ATOMIC_ACQUIRE, "agent");
            asm volatile("s_waitcnt vmcnt(0)" ::: "memory");
        }
    }
    __syncthreads();
}

__device__ __forceinline__ void tr_item(const float* W, int N, bf16_t* WT, int ldk, int k0, int n0, int drow0, const float* gk, LAS float* scr, int lane) {
    float wv[32];
#pragma unroll
    for (int i = 0; i < 32; ++i) { const int kk = 2 * i + (lane >> 5); wv[i] = W[(size_t)(k0 + kk) * N + n0 + (lane & 31)]; }
    if (gk) {
#pragma unroll
        for (int i = 0; i < 32; ++i) wv[i] *= gk[k0 + 2 * i + (lane >> 5)]; }
#pragma unroll
    for (int i = 0; i < 32; ++i) { const int kk = 2 * i + (lane >> 5); scr[kk * 33 + (lane & 31)] = wv[i]; }
    LDS_WAIT(); asm volatile("" ::: "memory");
    const int c = lane & 7;
#pragma unroll
    for (int j = 0; j < 4; ++j) { const int n = (lane >> 3) + 8 * j; const LAS float* s = scr + (8 * c) * 33 + n;
        u32x4 o; o.x = pk2(s[0 * 33], s[1 * 33]); o.y = pk2(s[2 * 33], s[3 * 33]); o.z = pk2(s[4 * 33], s[5 * 33]); o.w = pk2(s[6 * 33], s[7 * 33]);
        *(u32x4*)(WT + (size_t)(drow0 + n) * ldk + k0 + 8 * c) = o; }
    LDS_WAIT(); asm volatile("" ::: "memory");
}
__device__ __forceinline__ void tr_item8(const float* W, int N, unsigned char* WT, int ldk, int k0, int n0, int drow0, LAS float* scr, int lane) {
    float wv[32];
#pragma unroll
    for (int i = 0; i < 32; ++i) { const int kk = 2 * i + (lane >> 5); wv[i] = W[(size_t)(k0 + kk) * N + n0 + (lane & 31)]; }
    __builtin_amdgcn_sched_barrier(0);
#pragma unroll
    for (int i = 0; i < 32; ++i) { const int kk = 2 * i + (lane >> 5); scr[kk * 33 + (lane & 31)] = wv[i] * W8_MUL; }
    LDS_WAIT(); asm volatile("" ::: "memory");
    const int c = lane & 3;
#pragma unroll
    for (int j = 0; j < 2; ++j) { const int n = (lane >> 2) + 16 * j; const LAS float* s = scr + (16 * c) * 33 + n;
        u32x4 o; o.x = pk4_fp8(s[0 * 33], s[1 * 33], s[2 * 33], s[3 * 33]); o.y = pk4_fp8(s[4 * 33], s[5 * 33], s[6 * 33], s[7 * 33]);
        o.z = pk4_fp8(s[8 * 33], s[9 * 33], s[10 * 33], s[11 * 33]); o.w = pk4_fp8(s[12 * 33], s[13 * 33], s[14 * 33], s[15 * 33]);
        *(u32x4*)(WT + (size_t)(drow0 + n) * ldk + k0 + 16 * c) = o; }
    LDS_WAIT(); asm volatile("" ::: "memory");
}
constexpr int CI_IN = 16 * 67, CI_OUT = 16 * 32, CI_UQ = 3 * 12, CI_UKV = 2 * 16, CI_SMALL = CI_IN + CI_OUT + CI_UQ + CI_UKV, CI_E = 512, CI_MOE = 3 * 16 * CI_E;
__device__ __forceinline__ void conv_small_item(const Args& a, int l, int it, LAS float* scr, int lane) {
    unsigned char* ws = a.ws;
    if (it < CI_IN) { const int kb = it / 67, nb = it % 67; tr_item(arg_in(a, I_WIN) + (size_t)l * DM * INC, INC, (bf16_t*)(ws + WS_WIN) + (size_t)l * INCP * DM, DM, 64 * kb, 32 * nb, 32 * nb, nullptr, scr, lane); return; }
    it -= CI_IN;
    if (it < CI_OUT) { const int kb = it / 32, nb = it % 32; tr_item(arg_in(a, I_WOUT) + (size_t)l * DM * DM, DM, (bf16_t*)(ws + WS_WOUT) + (size_t)l * DM * DM, DM, 64 * kb, 32 * nb, 32 * nb, nullptr, scr, lane); return; }
    it -= CI_OUT;
    if (it < CI_UQ) { const int kb = it / 12, nb = it % 12; tr_item(arg_in(a, I_BWUQ) + (size_t)l * 192 * 384, 384, (bf16_t*)(ws + WS_WUQ) + (size_t)l * 2 * 512 * 256, 256, 64 * kb, 32 * nb, 32 * nb, arg_in(a, I_BQN) + l * 192, scr, lane); return; }
    it -= CI_UQ;
    { const int kb = it / 16, nb = it % 16; tr_item(arg_in(a, I_BWUKV) + (size_t)l * 128 * 512, 512, (bf16_t*)(ws + WS_WUQ) + ((size_t)l * 2 + 1) * 512 * 256, 256, 64 * kb, 32 * nb, 32 * nb, arg_in(a, I_BKVN) + l * 128, scr, lane); }
}
__device__ __forceinline__ void conv_moe_item(const Args& a, int l, int it, LAS float* scr, int lane) {
    unsigned char* ws = a.ws;
    const int e = it / (3 * CI_E), r = it % (3 * CI_E), which = r / CI_E, q = r % CI_E, kb = q / 32, nb = q % 32, n0 = 32 * nb;
    const size_t eo = ((size_t)l * NEXP + e) * DM * DM;
    if (which == 0)      tr_item8(arg_in(a, I_WGATE) + eo, DM, ws + WS_WGU + (size_t)l * WS_WL + (size_t)e * 2048 * DM, DM, 64 * kb, n0, (n0 >> 7) * 256 + (n0 & 127), scr, lane);
    else if (which == 1) tr_item8(arg_in(a, I_WUP) + eo, DM, ws + WS_WGU + (size_t)l * WS_WL + (size_t)e * 2048 * DM, DM, 64 * kb, n0, (n0 >> 7) * 256 + 128 + (n0 & 127), scr, lane);
    else                 tr_item8(arg_in(a, I_WDOWN) + eo, DM, ws + WS_WDN + (size_t)l * WS_WL + (size_t)e * DM * DM, DM, 64 * kb, n0, n0, scr, lane);
}
__device__ __forceinline__ void bg_convert(const Args& a, int l, int first, int n, int rank, int nranks, unsigned char* lds) {
    const TI ti = mk_ti(); LAS float* scr = (LAS float*)((LAS unsigned char*)lds + ti.wave * 16384);
    const int W = nranks * NWAVES;
    for (int it = first + rank * NWAVES + ti.wave; it < first + n; it += W) conv_moe_item(a, l, it, scr, ti.lane);
}
constexpr int BG0_A = 17000, BG0_B = 0;
constexpr int BG1_U = 4096, BG1_D = 5120, BG1_A = 8192;
__device__ __forceinline__ void mod_item(const Args& a, int item, unsigned char* lds, int tid) {
    const int l = item / 96, col0 = (item % 96) * 64;
    float* sil = (float*)lds;
    float* red = (float*)(lds + 12288);
    { float cv[6];
#pragma unroll
      for (int j = 0; j < 6; ++j) { const int i = tid + j * NTHREADS, r = i / DM, k = i % DM; cv[j] = (r < 2) ? arg_in(a, I_C)[r * DM + k] : arg_in(a, I_CCTX)[k]; }
#pragma unroll
      for (int j = 0; j < 6; ++j) sil[tid + j * NTHREADS] = siluf(cv[j]); }
    static_assert(3 * DM == 6 * NTHREADS, "conditioning staging");
    __syncthreads();
    const int col = tid & 63, kg = tid >> 6; const float* W = arg_in(a, I_WMOD) + (size_t)l * DM * 6144 + col0 + col;
    float a0 = 0.f, a1 = 0.f, a2 = 0.f;
#pragma unroll 64
    for (int k = kg * 128; k < kg * 128 + 128; ++k) { const float w = W[(size_t)k * 6144]; a0 += sil[k] * w; a1 += sil[DM + k] * w; a2 += sil[2 * DM + k] * w; }
    red[(kg * 3 + 0) * 64 + col] = a0; red[(kg * 3 + 1) * 64 + col] = a1; red[(kg * 3 + 2) * 64 + col] = a2;
    __syncthreads();
    if (tid < 192) { const int r = tid / 64, c = tid % 64; float s = 0.f;
#pragma unroll
        for (int g = 0; g < 8; ++g) s += red[(g * 3 + r) * 64 + c];
        ((float*)(a.ws + WS_MOD))[((size_t)l * 3 + r) * 6144 + col0 + c] = s + arg_in(a, I_BMOD)[l * 6144 + col0 + c]; }
    __syncthreads();
}

__device__ __forceinline__ void p0_prologue(const Args& a, unsigned char* lds) {
    const TI ti = mk_ti(); const int gw = ti.gw, ngw = ti.ngw, gtid = ti.gtid, ngt = ti.ngt, wave = ti.wave, lane = ti.lane;
    for (int it = blockIdx.x; it < 192; it += gridDim.x) mod_item(a, it, lds, ti.tid);
    LAS float* scr = (LAS float*)((LAS unsigned char*)lds + wave * 16384);
    for (int it = gw; it < 2 * CI_SMALL; it += ngw) {
        if (it < CI_SMALL) conv_small_item(a, 0, it, scr, lane);
        else conv_small_item(a, 1, it - CI_SMALL, scr, lane);
    }
    { unsigned zz_ = 0u; asm volatile("" : "+v"(zz_)); const u32x4 z = {zz_, zz_, zz_, zz_};
      constexpr int ZIN = 160 * 128, ZUQ1 = 384 * 8, ZUQ2 = 128 * 32, ZUKV = 512 * 16, ZL = ZIN + ZUQ1 + ZUQ2 + ZUKV;
      for (int i = gtid; i < 2 * ZL; i += ngt) { const int l = i / ZL; int q = i % ZL;
          if (q < ZIN) { *(u32x4*)((bf16_t*)(a.ws + WS_WIN) + ((size_t)l * INCP + INC) * DM + (size_t)q * 8) = z; continue; } q -= ZIN;
          bf16_t* uq = (bf16_t*)(a.ws + WS_WUQ) + (size_t)l * 2 * 512 * 256;
          if (q < ZUQ1) { *(u32x4*)(uq + (size_t)(q >> 3) * 256 + 192 + (q & 7) * 8) = z; continue; } q -= ZUQ1;
          if (q < ZUQ2) { *(u32x4*)(uq + (size_t)384 * 256 + (size_t)q * 8) = z; continue; } q -= ZUQ2;
          *(u32x4*)(uq + (size_t)512 * 256 + (size_t)(q >> 4) * 256 + 128 + (q & 15) * 8) = z; } }
    for (int i = gtid; i < 128 * 16 + 128 * 8; i += ngt) {
        if (i < 2048) { const int pos = i >> 4, k = i & 15; const float f = exp2f(-(float)k * (13.287712379549449f / 16.f)); const float ang = (float)pos * f; float* t = (float*)(a.ws + WS_TAB64) + 2 * i; t[0] = cosf(ang); t[1] = sinf(ang); }
        else { const int q = i - 2048, pos = q >> 3, k = q & 7; const float f = exp2f(-(float)k * (13.287712379549449f / 8.f)); const float ang = (float)pos * f; float* t = (float*)(a.ws + WS_TAB32) + 2 * q; t[0] = cosf(ang); t[1] = sinf(ang); }
    }
    if (gw < DEPTH) { const float* lp = arg_in(a, I_CLAM) + gw * 128;
        float p1 = 0.f, p2 = 0.f; if (lane < 32) { p1 = lp[lane] * lp[32 + lane]; p2 = lp[64 + lane] * lp[96 + lane]; }
        const float s1 = wave_sum(p1, lane), s2 = wave_sum(p2, lane);
        const float lam_init = 0.8f - 0.6f * expf(-0.3f * (float)gw);
        if (lane == 0) ((float*)(a.ws + WS_LAM))[gw] = expf(s1) - expf(s2) + lam_init; }
}

__device__ __forceinline__ int mod_row(int b, int t) { return t < CTXL ? 2 : b; }
__device__ __forceinline__ void modulate_row(const f32x4 (&v)[4], const float* g, const float* sh, const float* sc, bf16_t* hrow, int lane, f32x4 (*hout)[4] = nullptr) {
    float ss = 0.f;
#pragma unroll
    for (int j = 0; j < 4; ++j) ss += (v[j].x * v[j].x + v[j].y * v[j].y) + (v[j].z * v[j].z + v[j].w * v[j].w);
    const float rstd = rsqrtf(wave_sum(ss, lane) * (1.f / DM) + EPS);
#pragma unroll
    for (int j = 0; j < 4; ++j) { const int c = 4 * lane + 256 * j;
        const f32x4 gg = *(const f32x4*)(g + c), s1 = *(const f32x4*)(sc + c), s0 = *(const f32x4*)(sh + c);
        const f32x4 h = (v[j] * rstd) * gg * (s1 + 1.f) + s0;
        if (hout) (*hout)[j] = h;
        u32x2 w; w.x = pk2(h.x, h.y); w.y = pk2(h.z, h.w); *(u32x2*)(hrow + c) = w; }
}

struct ModVec { f32x4 g[4], s1[4], s0[4]; };
__device__ __forceinline__ void load_modvec(ModVec& mv, const float* g, const float* sh, const float* sc, int lane) {
#pragma unroll
    for (int j = 0; j < 4; ++j) { const int c = 4 * lane + 256 * j; mv.g[j] = *(const f32x4*)(g + c); mv.s1[j] = *(const f32x4*)(sc + c) + 1.f; mv.s0[j] = *(const f32x4*)(sh + c); }
}
template <bool FP8 = false>
__device__ __forceinline__ void modulate_row_c(const f32x4 (&v)[4], const ModVec& mv, bf16_t* hrow, int lane, f32x4 (*hout)[4] = nullptr) {
    float ss = 0.f;
#pragma unroll
    for (int j = 0; j < 4; ++j) ss += (v[j].x * v[j].x + v[j].y * v[j].y) + (v[j].z * v[j].z + v[j].w * v[j].w);
    const float rstd = rsqrtf(wave_sum(ss, lane) * (1.f / DM) + EPS);
#pragma unroll
    for (int j = 0; j < 4; ++j) { const int c = 4 * lane + 256 * j;
        const f32x4 h = (v[j] * rstd) * mv.g[j] * mv.s1[j] + mv.s0[j];
        if (hout) (*hout)[j] = h;
        if constexpr (FP8) *(unsigned*)((unsigned char*)hrow + c) = pk4_fp8(h.x, h.y, h.z, h.w);
        else { u32x2 w; w.x = pk2(h.x, h.y); w.y = pk2(h.z, h.w); *(u32x2*)(hrow + c) = w; } }
}

__device__ __forceinline__ void p1_norm1_l0(const Args& a) {
    const TI ti = mk_ti(); const int gw = ti.gw, ngw = ti.ngw, lane = ti.lane;
    bf16_t* X = (bf16_t*)(a.ws + WS_X); bf16_t* H = (bf16_t*)(a.ws + WS_H); const float* MOD = (const float*)(a.ws + WS_MOD);
    ModVec mv; int curmr = -1;
    for (int r0 = gw; r0 < NR; r0 += 2 * ngw) { f32x4 v[2][4];
#pragma unroll
        for (int q = 0; q < 2; ++q) { const int r = (r0 + q * ngw < NR) ? r0 + q * ngw : r0; const int b = r / RB, t = r % RB;
            const float* src = (t < CTXL) ? arg_in(a, I_CTX) + ((size_t)b * CTXL + t) * DM : arg_in(a, I_X) + ((size_t)b * SEQ + (t - CTXL)) * DM;
#pragma unroll
            for (int j = 0; j < 4; ++j) v[q][j] = *(const f32x4*)(src + 4 * lane + 256 * j); }
#pragma unroll
        for (int q = 0; q < 2; ++q) { const int r = r0 + q * ngw; if (r < NR) { const int b = r / RB, t = r % RB;
#pragma unroll
            for (int j = 0; j < 4; ++j) stx4(X + (size_t)r * DM + 4 * lane + 256 * j, v[q][j]);
            { const int mr = mod_row(b, t); if (mr != curmr) { curmr = mr; const float* m = MOD + (size_t)mr * 6144; load_modvec(mv, arg_in(a, I_GATTN), m, m + 1024, lane); } }
            modulate_row_c(v[q], mv, H + (size_t)r * DM, lane); } } }
}

__device__ __forceinline__ void rope_pair(float& x1, float& x2, const float* tab) { const float c = tab[0], s = tab[1]; const float y1 = x1 * c - x2 * s, y2 = x1 * s + x2 * c; x1 = y1; x2 = y2; }

struct P3Raw { u32x4 a1, a2, c1, c2, q8, kv8; f32x4 t64[4], t32[4]; };
__device__ __forceinline__ void p3_load(const Args& a, int rA, int rB, int lane, P3Raw& w) {
    const int hl = lane & 31; const int r = lane < 32 ? rA : rB;
    const bf16_t* pr = (const bf16_t*)(a.ws + WS_PROJ) + (size_t)r * INCP;
    { const float* T64 = (const float*)(a.ws + WS_TAB64); const float* T32 = (const float*)(a.ws + WS_TAB32);
      const int t = r % RB; const int p = t >= CTXL ? t - CTXL : 0, py = p >> 6, px = p & 63;
      const int part4 = hl & 3, part2 = hl & 1;
      const float* tab64 = T64 + ((part4 < 2 ? py : px) * 16 + 8 * (part4 & 1)) * 2; const float* tab32 = T32 + ((part2 == 0 ? py : px) * 8) * 2;
#pragma unroll
      for (int k = 0; k < 4; ++k) { w.t64[k] = *(const f32x4*)(tab64 + 4 * k); w.t32[k] = *(const f32x4*)(tab32 + 4 * k); } }
    { const int kh = (hl >> 2) & 3, part = hl & 3;
      const int sc_ = kh < 2 ? PA_K + 64 * kh : PD_K + 64 * (kh - 2);
      w.a1 = *(const u32x4*)(pr + sc_ + 8 * part); w.a2 = *(const u32x4*)(pr + sc_ + 32 + 8 * part); }
    { const int gr = hl >> 1, part = hl & 1; const int gg = gr < 12 ? gr : 8;
      const int sc_ = gg < 8 ? PC_K + 32 * gg : PB_KR;
      w.c1 = *(const u32x4*)(pr + sc_ + 8 * part); w.c2 = *(const u32x4*)(pr + sc_ + 16 + 8 * part); }
    w.q8 = *(const u32x4*)(pr + PB_CQ + 8 * (hl < 24 ? hl : 0));
    w.kv8 = *(const u32x4*)(pr + PB_CKV + 8 * (hl < 16 ? hl : 0));
}
__device__ __forceinline__ float sq8(const u32x4& v) { float s = 0.f;
#pragma unroll
    for (int k = 0; k < 4; ++k) { const float lo = bflo(v[k]), hi = bfhi(v[k]); s += lo * lo + hi * hi; } return s; }
struct P3Gain { float g1[8], g2[8]; };
template <bool USEG>
__device__ __forceinline__ void rot8(const u32x4& x1, const u32x4& x2, const f32x4 (&t)[4], bool rot, float s1, const P3Gain& g, float scale, u32x4& y1, u32x4& y2) {
    float a[8], b[8];
#pragma unroll
    for (int k = 0; k < 4; ++k) { a[2 * k] = bflo(x1[k]); a[2 * k + 1] = bfhi(x1[k]); b[2 * k] = bflo(x2[k]); b[2 * k + 1] = bfhi(x2[k]); }
    if constexpr (USEG) {
#pragma unroll
        for (int k = 0; k < 8; ++k) { a[k] *= s1 * g.g1[k]; b[k] *= s1 * g.g2[k]; } }
    if (rot) {
#pragma unroll
        for (int k = 0; k < 8; ++k) { const float c = t[k >> 1][(k & 1) * 2], s = t[k >> 1][(k & 1) * 2 + 1]; const float y = a[k] * c - b[k] * s, z = a[k] * s + b[k] * c; a[k] = y; b[k] = z; } }
#pragma unroll
    for (int k = 0; k < 4; ++k) { y1[k] = pk2(a[2 * k] * scale, a[2 * k + 1] * scale); y2[k] = pk2(b[2 * k] * scale, b[2 * k + 1] * scale); }
}
__device__ __forceinline__ float rdl(float v, int l_) { return __builtin_bit_cast(float, __builtin_amdgcn_readlane(__builtin_bit_cast(int, v), l_)); }
__device__ __forceinline__ void p3_compute(const Args& a, int l, int rA, int rB, bool validB, int lane, const P3Raw& w, const P3Gain& gg) {
    bf16_t* AT = (bf16_t*)(a.ws + WS_ATT); float* RS = (float*)(a.ws + WS_RS);
    const int hl = lane & 31; const bool hiHalf = lane >= 32; const int r = hiHalf ? rB : rA; const bool valid = !hiHalf || validB;
    const int t = r % RB; const bool lat = t >= CTXL;
    { const int kh = (hl >> 2) & 3, part = hl & 3;
      float ss = quad_sum(sq8(w.a1) + sq8(w.a2));
      if (valid && hl < 16) {
          bf16_t* dst = kh < 2 ? AT + AO_KA + (size_t)r * 128 + 64 * kh : AT + AO_KD + (size_t)r * 128 + 64 * (kh - 2);
          const float rs = kh >= 2 ? rsqrtf(ss * (1.f / 64.f) + EPS) : 1.f;
          u32x4 y1, y2; rot8<true>(w.a1, w.a2, w.t64, lat, rs, gg, 1.f, y1, y2);
          *(u32x4*)(dst + 8 * part) = y1; *(u32x4*)(dst + 32 + 8 * part) = y2; } }
    { const int gr = hl >> 1, part = hl & 1;
      if (valid && hl < 24) {
          u32x4 y1, y2; rot8<false>(w.c1, w.c2, w.t32, lat, 1.f, gg, 1.f, y1, y2);
          bf16_t* dst = gr < 8 ? AT + AO_KC + (size_t)r * 256 + 32 * gr : AT + AO_KB + (size_t)r * 384 + 64 + (gr - 8) * 96;
          *(u32x4*)(dst + 8 * part) = y1; *(u32x4*)(dst + 16 + 8 * part) = y2; } }
    { float s1 = hl < 24 ? sq8(w.q8) : 0.f, s2 = hl < 16 ? sq8(w.kv8) : 0.f;
      s1 += dppf<0x111, 0xF>(s1); s1 += dppf<0x112, 0xF>(s1); s1 += dppf<0x114, 0xF>(s1); s1 += dppf<0x118, 0xF>(s1);
      s2 += dppf<0x111, 0xF>(s2); s2 += dppf<0x112, 0xF>(s2); s2 += dppf<0x114, 0xF>(s2); s2 += dppf<0x118, 0xF>(s2);
      const float a1 = rdl(s1, 15) + rdl(s1, 31), b1 = rdl(s1, 47) + rdl(s1, 63), a2 = rdl(s2, 15), b2 = rdl(s2, 47);
      if (valid && hl == 0) { RS[2 * r] = rsqrtf((hiHalf ? b1 : a1) * (1.f / 192.f) + EPS); RS[2 * r + 1] = rsqrtf((hiHalf ? b2 : a2) * (1.f / 128.f) + EPS); } }
}
__device__ __forceinline__ void p3_rows(const Args& a, int l, int brank, int nbranks) {
    const TI ti = mk_ti(); const int gw = brank * NWAVES + ti.wave, ngw = nbranks * NWAVES, lane = ti.lane;
    P3Gain gg;
    { const int hl = lane & 31, kh = (hl >> 2) & 3, part = hl & 3; const float* gn = kh >= 2 ? arg_in(a, I_DKN) + l * 64 : nullptr;
#pragma unroll
      for (int k = 0; k < 8; ++k) { gg.g1[k] = gn ? gn[8 * part + k] : 1.f; gg.g2[k] = gn ? gn[32 + 8 * part + k] : 1.f; } }
    for (int r = gw; r < NR; r += 4 * ngw) {
        const int rB0 = r + ngw, rA1 = r + 2 * ngw, rB1 = r + 3 * ngw; const bool vB0 = rB0 < NR, vA1 = rA1 < NR, vB1 = rB1 < NR;
        P3Raw wa, wb; p3_load(a, r, vB0 ? rB0 : r, lane, wa); p3_load(a, vA1 ? rA1 : r, vB1 ? rB1 : r, lane, wb);
        p3_compute(a, l, r, vB0 ? rB0 : r, vB0, lane, wa, gg); if (vA1) p3_compute(a, l, rA1, vB1 ? rB1 : rA1, vB1, lane, wb, gg); }
}

__device__ __forceinline__ void p3c_rows(const Args& a) {
    const TI ti = mk_ti(); const int gw = ti.gw, ngw = ti.ngw, lane = ti.lane;
    bf16_t* AT = (bf16_t*)(a.ws + WS_ATT); const float* T32 = (const float*)(a.ws + WS_TAB32); const float* RS = (const float*)(a.ws + WS_RS);
    const float CB = 0.10206207261596575f * LOG2E;
    const int h = lane >> 4, i = lane & 15; const bool ropel = i < 4; const int i4 = ropel ? i : 0;
    for (int r0 = gw; r0 < NR; r0 += 2 * ngw) {
        u32x2 wq[2], x1w[2], x2w[2]; u32x4 wk[2]; float rsq[2], rsk[2]; f32x4 tb[2][2];
#pragma unroll
        for (int q = 0; q < 2; ++q) { const int r = (r0 + q * ngw < NR) ? r0 + q * ngw : r0;
            const bf16_t* qbr = AT + AO_QBR + (size_t)r * 512; const bf16_t* kvr = AT + AO_KVBR + (size_t)r * 512;
            const int t = r % RB; const int pp = t >= CTXL ? t - CTXL : 0, py = pp >> 6, px = pp & 63;
            const float* tab = T32 + (((i4 < 2 ? py : px) * 8) + 4 * (i4 & 1)) * 2;
            wq[q] = *(const u32x2*)(qbr + h * 96 + 4 * i); x1w[q] = *(const u32x2*)(qbr + h * 96 + 64 + 4 * i4); x2w[q] = *(const u32x2*)(qbr + h * 96 + 80 + 4 * i4);
            wk[q] = *(const u32x4*)(kvr + 8 * lane); rsq[q] = RS[2 * r]; rsk[q] = RS[2 * r + 1]; tb[q][0] = *(const f32x4*)tab; tb[q][1] = *(const f32x4*)(tab + 4); }
#pragma unroll
        for (int q = 0; q < 2; ++q) { const int r = r0 + q * ngw; if (r < NR) {
            const int t = r % RB; const bool lat = t >= CTXL;
            const float rq = rsq[q] * CB, rkv = rsk[q];
            bf16_t* qb = AT + AO_QB + (size_t)r * 384; bf16_t* kb = AT + AO_KB + (size_t)r * 384; bf16_t* vb = AT + AO_VB + (size_t)r * 256;
            { const u32x2 w = wq[q]; u32x2 o; o.x = pk2(bflo(w.x) * rq, bfhi(w.x) * rq); o.y = pk2(bflo(w.y) * rq, bfhi(w.y) * rq); *(u32x2*)(qb + h * 96 + 4 * i) = o; }
            if (ropel) { float x1[4] = {bflo(x1w[q].x), bfhi(x1w[q].x), bflo(x1w[q].y), bfhi(x1w[q].y)}, x2[4] = {bflo(x2w[q].x), bfhi(x2w[q].x), bflo(x2w[q].y), bfhi(x2w[q].y)};
              if (lat) {
#pragma unroll
                  for (int k = 0; k < 4; ++k) { const float c = tb[q][k >> 1][(k & 1) * 2], sn = tb[q][k >> 1][(k & 1) * 2 + 1]; const float y1 = x1[k] * c - x2[k] * sn, y2 = x1[k] * sn + x2[k] * c; x1[k] = y1; x2[k] = y2; } }
              u32x2 o1, o2; o1.x = pk2(x1[0] * rq, x1[1] * rq); o1.y = pk2(x1[2] * rq, x1[3] * rq); o2.x = pk2(x2[0] * rq, x2[1] * rq); o2.y = pk2(x2[2] * rq, x2[3] * rq);
              *(u32x2*)(qb + h * 96 + 64 + 4 * i) = o1; *(u32x2*)(qb + h * 96 + 80 + 4 * i) = o2; }
            { const u32x4 w = wk[q]; u32x4 o;
              o.x = pk2(bflo(w.x) * rkv, bfhi(w.x) * rkv); o.y = pk2(bflo(w.y) * rkv, bfhi(w.y) * rkv); o.z = pk2(bflo(w.z) * rkv, bfhi(w.z) * rkv); o.w = pk2(bflo(w.w) * rkv, bfhi(w.w) * rkv);
              const int within = (8 * lane) & 127;
              bf16_t* d_ = within < 64 ? kb + h * 96 + within : vb + h * 64 + within - 64; *(u32x4*)d_ = o; } } }
    }
}

__device__ __forceinline__ void p6_norm2_router(const Args& a, int l, bool last, int rows, int brank, int nbranks, unsigned char* lds) {
    const TI ti = mk_ti(); const int gw = brank * NWAVES + ti.wave, ngw = nbranks * NWAVES, lane = ti.lane;
    const int NI = rows == 0 ? NR : rows == 1 ? NBATCH * SEQ : NBATCH * CTXL;
#define P6_ROW(idx) (rows == 0 ? (idx) : rows == 1 ? (idx) + CTXL + ((idx) >= SEQ ? CTXL : 0) : (idx) + ((idx) >= CTXL ? SEQ : 0))
    float* wr = (float*)lds;
    { const float* W = arg_in(a, I_WROUTER) + (size_t)l * DM * NEXP;
      f32x4 wv[8];
#pragma unroll
      for (int k = 0; k < 8; ++k) { const int i = ti.tid + k * NTHREADS; const int c = i >> 2, q = i & 3; wv[k] = *(const f32x4*)(W + c * 16 + q * 4); }
#pragma unroll
      for (int k = 0; k < 8; ++k) { const int i = ti.tid + k * NTHREADS; const int c = i >> 2, q = i & 3; const int rho = ((c >> 8) * 4 + (c & 3)) * 64 + ((c >> 2) & 63);
          *(f32x4*)(wr + ((size_t)q * DM + rho) * 4) = wv[k]; } }
    static_assert(DM * 4 == 8 * NTHREADS, "router weight staging");
    __syncthreads();
    const bf16_t* X = (const bf16_t*)(a.ws + WS_X); bf16_t* H = (bf16_t*)(a.ws + WS_H); const float* MOD = (const float*)(a.ws + WS_MOD) + (size_t)l * 3 * 6144; float* AFF = (float*)(a.ws + WS_AFF);
    f32x4 vn[4];
#pragma unroll
    for (int j = 0; j < 4; ++j) vn[j] = ldx4(X + (size_t)P6_ROW(gw < NI ? gw : 0) * DM + 4 * lane + 256 * j);
    ModVec mv; int curmr = -1;
    const int myexp = ((lane >> 5) & 1) * 8 + ((lane >> 4) & 1) * 4 + ((lane >> 3) & 1) * 2 + ((lane >> 2) & 1);
    for (int idx = gw; idx < NI; idx += ngw) { const int r = P6_ROW(idx); const int b = r / RB, t = r % RB;
        f32x4 v[4], h[4];
#pragma unroll
        for (int j = 0; j < 4; ++j) v[j] = vn[j];
        { const int rn = P6_ROW((idx + ngw < NI) ? idx + ngw : idx);
#pragma unroll
          for (int j = 0; j < 4; ++j) vn[j] = ldx4(X + (size_t)rn * DM + 4 * lane + 256 * j); }
        if (last && t < CTXL) continue;
        { const int mr = mod_row(b, t); if (mr != curmr) { const float* m = MOD + (size_t)mr * 6144; load_modvec(mv, arg_in(a, I_GFFN) + l * DM, m + 3072, m + 4096, lane); curmr = mr; } }
        modulate_row_c<true>(v, mv, (bf16_t*)((unsigned char*)H + (size_t)r * DM), lane, &h);
        float lg[16];
#pragma unroll
        for (int e = 0; e < 16; ++e) lg[e] = 0.f;
#pragma unroll
        for (int j = 0; j < 4; ++j) {
            f32x4 ww[4][4];
#pragma unroll
            for (int i = 0; i < 4; ++i)
#pragma unroll
                for (int q = 0; q < 4; ++q) ww[i][q] = *(const f32x4*)(wr + ((size_t)q * DM + (j * 4 + i) * 64 + lane) * 4);
#pragma unroll
            for (int i = 0; i < 4; ++i) { const float hv = h[j][i];
#pragma unroll
                for (int q = 0; q < 4; ++q) { lg[4 * q] += hv * ww[i][q].x; lg[4 * q + 1] += hv * ww[i][q].y; lg[4 * q + 2] += hv * ww[i][q].z; lg[4 * q + 3] += hv * ww[i][q].w; } }
        }
        float v8[8], v4[4], v2[2], v1;
#pragma unroll
        for (int k = 0; k < 8; ++k) { const bool up = lane & 32; const float mine = up ? lg[k + 8] : lg[k], oth = up ? lg[k] : lg[k + 8]; v8[k] = mine + shx(oth, 32, lane); }
#pragma unroll
        for (int k = 0; k < 4; ++k) { const bool up = lane & 16; const float mine = up ? v8[k + 4] : v8[k], oth = up ? v8[k] : v8[k + 4]; v4[k] = mine + shx(oth, 16, lane); }
#pragma unroll
        for (int k = 0; k < 2; ++k) { const bool up = lane & 8; const float mine = up ? v4[k + 2] : v4[k], oth = up ? v4[k] : v4[k + 2]; v2[k] = mine + shx(oth, 8, lane); }
        { const bool up = lane & 4; const float mine = up ? v2[1] : v2[0], oth = up ? v2[0] : v2[1]; v1 = mine + shx(oth, 4, lane); }
        v1 += shx(v1, 1, lane); v1 += shx(v1, 2, lane);
        float mx = v1;
#pragma unroll
        for (int o = 4; o < 64; o <<= 1) mx = fmaxf(mx, shx(mx, o, lane));
        const float pe = __expf(v1 - mx); float den = pe;
#pragma unroll
        for (int o = 4; o < 64; o <<= 1) den += shx(den, o, lane);
        if ((lane & 3) == 0) AFF[((size_t)b * NEXP + myexp) * RB + t] = pe / den;
    }
#undef P6_ROW
    asm volatile("s_waitcnt vmcnt(0)" ::: "memory");
    __syncthreads();
}

__device__ __forceinline__ void p7_topk(const Args& a, int q, unsigned char* lds) {
    const TI ti = mk_ti(); const int tid = ti.tid, lane = ti.lane, wave = ti.wave;
    int* hist = (int*)lds;
    int* selv = (int*)(lds + 1024);
    int* wsum = (int*)(lds + 1024 + 64);
    const bool isctx = q >= 32; const int g = isctx ? q - 32 : q, b = g >> 4, e = g & 15;
    const int n = isctx ? CTXL : SEQ, k = isctx ? CAPC : CAPL;
    const float* src = (const float*)(a.ws + WS_AFF) + (size_t)g * RB + (isctx ? 0 : CTXL);
    const int yrow0 = isctx ? (128 + e) * 256 + b * CAPC : g * CAPL, tok0 = b * RB + (isctx ? 0 : CTXL);
    unsigned key[16];
#pragma unroll
    for (int j4 = 0; j4 < 4; ++j4) { const int i0 = tid * 16 + j4 * 4; u32x4 kv = {0u, 0u, 0u, 0u}; if (i0 < n) kv = *(const u32x4*)(src + i0); key[j4 * 4] = kv.x; key[j4 * 4 + 1] = kv.y; key[j4 * 4 + 2] = kv.z; key[j4 * 4 + 3] = kv.w; }
    unsigned prefix = 0u, mask = 0u; int kk = k;
    for (int pass = 0; pass < 4; ++pass) { const int shift = 24 - 8 * pass;
        if (tid < 256) hist[tid] = 0;
        __syncthreads();
#pragma unroll
        for (int j = 0; j < 16; ++j) if ((key[j] & mask) == prefix) atomicAdd(&hist[(key[j] >> shift) & 255u], 1);
        __syncthreads();
        if (wave == 0) {
            const int h0 = hist[4 * lane], h1 = hist[4 * lane + 1], h2 = hist[4 * lane + 2], h3 = hist[4 * lane + 3];
            const int s = h0 + h1 + h2 + h3; int incl = s;
#pragma unroll
            for (int o = 1; o < 64; o <<= 1) { const int v = shidx(incl, (lane + o) & 63); if (lane + o < 64) incl += v; }
            int cum = incl - s;
            if (cum < kk && cum + s >= kk) {
                int d = 4 * lane + 3;
                if (cum + h3 >= kk) { d = 4 * lane + 3; } else { cum += h3; if (cum + h2 >= kk) d = 4 * lane + 2; else { cum += h2; if (cum + h1 >= kk) d = 4 * lane + 1; else { cum += h1; d = 4 * lane; } } }
                selv[0] = d; selv[1] = kk - cum; }
        }
        __syncthreads();
        prefix |= (unsigned)selv[0] << shift; mask |= 255u << shift; kk = selv[1];
        __syncthreads();
    }
    int cgt = 0, ceq = 0;
#pragma unroll
    for (int j = 0; j < 16; ++j) { cgt += key[j] > prefix ? 1 : 0; ceq += key[j] == prefix ? 1 : 0; }
    int pk = cgt | (ceq << 16), incl = pk;
#pragma unroll
    for (int o = 1; o < 64; o <<= 1) { const int v = shidx(incl, (lane - o) & 63); if (lane >= o) incl += v; }
    if (lane == 63) wsum[wave] = incl;
    __syncthreads();
    int base = 0, total = 0;
#pragma unroll
    for (int w = 0; w < 8; ++w) { const int v = wsum[w]; if (w < wave) base += v; total += v; }
    int excl = base + incl - pk; int rgt = excl & 0xffff, req = excl >> 16; const int tgt = total & 0xffff;
    int* IDX = (int*)(a.ws + WS_IDX); float* GATEY = (float*)(a.ws + WS_GATEY); int* SLOT = (int*)(a.ws + WS_SLOT);
#pragma unroll
    for (int j = 0; j < 16; ++j) { const int i = tid * 16 + j; if (i < n) { int slot = -1;
        if (key[j] > prefix) slot = rgt++; else if (key[j] == prefix) { if (req < kk) slot = tgt + req; ++req; }
        const int row = tok0 + i;
        if (slot >= 0) { IDX[yrow0 + slot] = row; GATEY[yrow0 + slot] = __uint_as_float(key[j]); SLOT[(size_t)row * 16 + e] = yrow0 + slot; } else SLOT[(size_t)row * 16 + e] = -1; } }
    if (isctx && b == 0) { for (int i = tid; i < 192; i += NTHREADS) IDX[(128 + e) * 256 + 64 + i] = 0; }
    __syncthreads();
}

__device__ __forceinline__ void p10_combine(const Args& a, int l, bool last, float dbg, float dbgmul) {
    constexpr int NH = 2;
    const TI ti = mk_ti(); const int gw = ti.gw, ngw = ti.ngw, lane = ti.lane;
    bf16_t* X = (bf16_t*)(a.ws + WS_X); bf16_t* H = (bf16_t*)(a.ws + WS_H); const float* MOD = (const float*)(a.ws + WS_MOD);
    const unsigned char* Y = a.ws + WS_ATT;   const float* GATEY = (const float*)(a.ws + WS_GATEY); const int* SLOT = (const int*)(a.ws + WS_SLOT);
    ModVec mv; f32x4 gtv[4]; int curmr = -1;
    for (int r0 = gw; r0 < NR; r0 += 2 * ngw) {
        f32x4 v[2][4]; int myslot[2]; unsigned msk[2]; int s2[2][NH]; float g2[2][NH]; unsigned y2[2][NH][4];
#pragma unroll
        for (int q = 0; q < 2; ++q) { const int r = (r0 + q * ngw < NR) ? r0 + q * ngw : r0; myslot[q] = SLOT[(size_t)r * 16 + (lane & 15)];
#pragma unroll
            for (int j = 0; j < 4; ++j) v[q][j] = ldx4(X + (size_t)r * DM + 4 * lane + 256 * j); }
#pragma unroll
        for (int q = 0; q < 2; ++q) { msk[q] = (unsigned)(__ballot(myslot[q] >= 0) & 0xffffull);
#pragma unroll
            for (int k = 0; k < NH; ++k) { const bool has = msk[q] != 0u; const int e = has ? __builtin_ctz(msk[q]) : 0; const int s = shidx(myslot[q], e); s2[q][k] = has ? s : 0; if (has) msk[q] &= msk[q] - 1u; g2[q][k] = has ? 1.f : 0.f; } }
#pragma unroll
        for (int q = 0; q < 2; ++q)
#pragma unroll
            for (int k = 0; k < NH; ++k) { g2[q][k] *= GATEY[s2[q][k]]; const unsigned char* yr = Y + (size_t)s2[q][k] * DM;
#pragma unroll
                for (int j = 0; j < 4; ++j) y2[q][k][j] = *(const unsigned*)(yr + 4 * lane + 256 * j); }
#pragma unroll
        for (int q = 0; q < 2; ++q) { const int r = r0 + q * ngw; if (r >= NR) continue; const int b = r / RB, t = r % RB; if (last && t < CTXL) continue;
            f32x4 acc[4];
#pragma unroll
            for (int j = 0; j < 4; ++j) { acc[j] = (f32x4){0.f, 0.f, 0.f, 0.f};
#pragma unroll
                for (int k = 0; k < NH; ++k) { const int w = (int)y2[q][k][j]; const f32x2 lo = __builtin_amdgcn_cvt_pk_f32_fp8(w, false), hi = __builtin_amdgcn_cvt_pk_f32_fp8(w, true); acc[j] += (f32x4){lo.x, lo.y, hi.x, hi.y} * g2[q][k]; } }
            unsigned m = msk[q];
            while (m) { const int e = __builtin_ctz(m); m &= m - 1u; const int s = shidx(myslot[q], e); const float g = GATEY[s]; const unsigned char* yr = Y + (size_t)s * DM;
#pragma unroll
                for (int j = 0; j < 4; ++j) { const int w = *(const int*)(yr + 4 * lane + 256 * j); const f32x2 lo = __builtin_amdgcn_cvt_pk_f32_fp8(w, false), hi = __builtin_amdgcn_cvt_pk_f32_fp8(w, true); acc[j] += (f32x4){lo.x, lo.y, hi.x, hi.y} * g; } }
            { const int mr = mod_row(b, t); if (mr != curmr) { curmr = mr; const float* gt = MOD + ((size_t)l * 3 + mr) * 6144 + 5120;
#pragma unroll
                for (int j = 0; j < 4; ++j) gtv[j] = *(const f32x4*)(gt + 4 * lane + 256 * j);
                if (!last) { const float* mm = MOD + ((size_t)(l + 1) * 3 + mr) * 6144; load_modvec(mv, arg_in(a, I_GATTN) + (l + 1) * DM, mm, mm + 1024, lane); } } }
#pragma unroll
            for (int j = 0; j < 4; ++j) v[q][j] += gtv[j] * acc[j] * dbg;
            if (!last) {
#pragma unroll
                for (int j = 0; j < 4; ++j) stx4(X + (size_t)r * DM + 4 * lane + 256 * j, v[q][j]);
                modulate_row_c(v[q], mv, H + (size_t)r * DM, lane);
            } else {
                float ss = 0.f;
#pragma unroll
                for (int j = 0; j < 4; ++j) ss += (v[q][j].x * v[q][j].x + v[q][j].y * v[q][j].y) + (v[q][j].z * v[q][j].z + v[q][j].w * v[q][j].w);
                const float rstd = rsqrtf(wave_sum(ss, lane) * (1.f / DM) + EPS);
                float* o = a.out + ((size_t)b * SEQ + (t - CTXL)) * DM;
#pragma unroll
                for (int j = 0; j < 4; ++j) if (dbg != 0.f) *(f32x4*)(o + 4 * lane + 256 * j) = v[q][j] * (rstd * dbgmul) * *(const f32x4*)(arg_in(a, I_GFINAL) + 4 * lane + 256 * j);
            }
        }
    }
}
#if DBGCHK
constexpr size_t WS_DBG = 32 * 1024;
__device__ __forceinline__ void dbg_fail(const Args& a, int id) { atomicAdd((int*)(a.ws + WS_DBG) + id, 1); }
__device__ __forceinline__ bool dbg_bad(float got, float ref) { return !(fabsf(got - ref) <= 0.03f + 0.03f * fabsf(ref)); }
__device__ __forceinline__ bool dbg_bad8(float got, float ref) { return !(fabsf(got - ref) <= 0.25f + 0.12f * fabsf(ref)); }
__device__ __forceinline__ float dbg_fp8(unsigned char v) { return __builtin_amdgcn_cvt_f32_fp8((int)v, 0); }
__device__ __forceinline__ unsigned dbg_hash(unsigned x) { x ^= x >> 16; x *= 0x7feb352du; x ^= x >> 15; x *= 0x846ca68bu; x ^= x >> 16; return x; }

__device__ __forceinline__ void dbg_chk_inproj(const Args& a, int l, int id) {
    const TI ti = mk_ti(); const int r = dbg_hash(ti.gw * 7919u + 13u) % NR, c = (dbg_hash(ti.gw) % (INC - 64)) + ti.lane;
    const bf16_t* h = (const bf16_t*)(a.ws + WS_H) + (size_t)r * DM; const float* W = arg_in(a, I_WIN) + (size_t)l * DM * INC + c;
    float s = 0.f; for (int k = 0; k < DM; ++k) s += bf2f(h[k]) * W[(size_t)k * INC];
    const float got = bf2f(((const bf16_t*)(a.ws + WS_PROJ))[(size_t)r * INCP + c]);
    if (dbg_bad(got, s)) dbg_fail(a, id);
}
__device__ __forceinline__ void dbg_chk_bup(const Args& a, int l, int id) {
    const TI ti = mk_ti(); const int r = dbg_hash(ti.gw * 7919u + 17u) % NR; const bf16_t* pr = (const bf16_t*)(a.ws + WS_PROJ) + (size_t)r * INCP; const bf16_t* AT = (const bf16_t*)(a.ws + WS_ATT);
    { const int c = (dbg_hash(ti.gw) % (384 - 64)) + ti.lane; float s = 0.f;
      for (int k = 0; k < 192; ++k) s += bf2f(pr[PB_CQ + k]) * arg_in(a, I_BQN)[l * 192 + k] * arg_in(a, I_BWUQ)[(size_t)l * 192 * 384 + (size_t)k * 384 + c];
      if (dbg_bad(bf2f(AT[AO_QBR + (size_t)r * 512 + c]), s)) dbg_fail(a, id); }
    { const int c = (dbg_hash(ti.gw + 5u) % (512 - 64)) + ti.lane; float s = 0.f;
      for (int k = 0; k < 128; ++k) s += bf2f(pr[PB_CKV + k]) * arg_in(a, I_BKVN)[l * 128 + k] * arg_in(a, I_BWUKV)[(size_t)l * 128 * 512 + (size_t)k * 512 + c];
      if (dbg_bad(bf2f(AT[AO_KVBR + (size_t)r * 512 + c]), s)) dbg_fail(a, id + 1); }
}
__device__ __forceinline__ void dbg_chk_moe(const Args& a, int l, bool last, int id) {
    const TI ti = mk_ti(); const int ny = last ? 128 * 256 : YROWS;
    int yr = dbg_hash(ti.gw * 31u + 3u) % ny; if (yr >= 128 * 256 && (yr & 255) >= 64) yr &= ~192;
    const int pm = yr >> 8, e = pm < 128 ? (pm >> 2) & 15 : pm - 128; const int c = (dbg_hash(ti.gw + 77u) % (DM - 64)) + ti.lane;
    const int row = ((const int*)(a.ws + WS_IDX))[yr]; const unsigned char* h = (const unsigned char*)(a.ws + WS_H) + (size_t)row * DM;
    const size_t eo = ((size_t)l * NEXP + e) * DM * DM;
    { float g = 0.f, u = 0.f; for (int k = 0; k < DM; ++k) { const float hv = dbg_fp8(h[k]); g += hv * arg_in(a, I_WGATE)[eo + (size_t)k * DM + c]; u += hv * arg_in(a, I_WUP)[eo + (size_t)k * DM + c]; }
      const float ref = g / (1.f + __expf(-g)) * u; if (dbg_bad8(dbg_fp8(((const unsigned char*)(a.ws + WS_PROJ))[(size_t)yr * DM + c]), ref)) dbg_fail(a, id); }
    { const unsigned char* act = (const unsigned char*)(a.ws + WS_PROJ) + (size_t)yr * DM; float s = 0.f; for (int k = 0; k < DM; ++k) s += dbg_fp8(act[k]) * arg_in(a, I_WDOWN)[eo + (size_t)k * DM + c];
      if (dbg_bad8(bf2f(((const bf16_t*)(a.ws + WS_ATT))[(size_t)yr * DM + c]), s)) dbg_fail(a, id + 1); }
}
__device__ __forceinline__ void dbg_chk_topk(const Args& a, bool last, int id, unsigned char* lds) {
    const TI ti = mk_ti(); float* red = (float*)lds; int* redi = (int*)(lds + 4096);
    const int np = last ? 32 : 64;
    for (int q = blockIdx.x; q < np; q += gridDim.x) { const bool isctx = q >= 32; const int g = isctx ? q - 32 : q, b = g >> 4, e = g & 15, n = isctx ? CTXL : SEQ, k = isctx ? CAPC : CAPL;
        const float* aff = (const float*)(a.ws + WS_AFF) + (size_t)g * RB + (isctx ? 0 : CTXL); const int* SLOT = (const int*)(a.ws + WS_SLOT); const int tok0 = b * RB + (isctx ? 0 : CTXL);
        float mns = 1e30f, mxu = -1e30f; int cnt = 0;
        for (int i = ti.tid; i < n; i += NTHREADS) { const int s = SLOT[(size_t)(tok0 + i) * 16 + e]; if (s >= 0) { mns = fminf(mns, aff[i]); ++cnt; } else mxu = fmaxf(mxu, aff[i]); }
        red[ti.tid] = mns; red[512 + ti.tid] = mxu; redi[ti.tid] = cnt; __syncthreads();
        if (ti.tid == 0) { float A = 1e30f, B = -1e30f; int C = 0; for (int i = 0; i < NTHREADS; ++i) { A = fminf(A, red[i]); B = fmaxf(B, red[512 + i]); C += redi[i]; } if (C != k || A < B) dbg_fail(a, id); }
        __syncthreads(); }
}
template <int DK>
__device__ __forceinline__ void dbg_attn_row(const bf16_t* Q, int qp, int qc, const bf16_t* K, int kp, int kc, const bf16_t* V, int vp, int vc, size_t rowb, int t, bool window, float sink2, float (&o)[64]) {
    float q[DK];
#pragma unroll
    for (int d = 0; d < DK; ++d) q[d] = bf2f(Q[(rowb + t) * qp + qc + d]);
    float m = -1e30f, l = 0.f;
#pragma unroll
    for (int d = 0; d < 64; ++d) o[d] = 0.f;
    const int nk = t < CTXL ? CTXL : RB;
    for (int kk = 0; kk < nk; ++kk) {
        const bf16_t* kr = K + (rowb + kk) * kp + kc; float s = 0.f;
#pragma unroll
        for (int d = 0; d < DK; ++d) s += q[d] * bf2f(kr[d]);
        const bool valid = !(window && t >= CTXL && kk >= CTXL && (kk - t > 128 || t - kk > 128));
        if (valid) { const float mn = fmaxf(m, s), f = exp2f(m - mn), p = exp2f(s - mn); l = l * f + p; const bf16_t* vr = V + (rowb + kk) * vp + vc;
#pragma unroll
            for (int d = 0; d < 64; ++d) o[d] = o[d] * f + p * bf2f(vr[d]);
            m = mn; }
    }
    l += exp2f(sink2 - m);
    const float il = 1.f / l;
#pragma unroll
    for (int d = 0; d < 64; ++d) o[d] *= il;
}
__device__ __forceinline__ void dbg_chk_attn(const Args& a, int l, bool last, int id) {
    const TI ti = mk_ti(); const bf16_t* AT = (const bf16_t*)(a.ws + WS_ATT); const bf16_t* PROJ = (const bf16_t*)(a.ws + WS_PROJ); const bf16_t* MIX = (const bf16_t*)(a.ws + WS_MIX);
    const int mixer = ti.gw & 3, bh = (ti.gw >> 2) & 7, b = bh >> 2, h = bh & 3; const size_t rowb = (size_t)b * RB;
    int t = CTXL + (((ti.gw >> 5) * 64 + ti.lane) * 131 + 7) % SEQ; if (!last && (ti.gw >> 5) == 0) t = (ti.lane * 37) % CTXL;
    float o[64], ref[64];
    if (mixer == 0) dbg_attn_row<64>(AT + AO_QA, 256, h * 64, AT + AO_KA, 128, (h >> 1) * 64, PROJ, INCP, PA_V + (h >> 1) * 64, rowb, t, true, arg_in(a, I_ASINK)[l * 4 + h] * LOG2E, o);
    else if (mixer == 1) dbg_attn_row<96>(AT + AO_QB, 384, h * 96, AT + AO_KB, 384, h * 96, AT + AO_VB, 256, h * 64, rowb, t, false, -1e30f, o);
    else if (mixer == 3) dbg_attn_row<64>(AT + AO_QD, 256, h * 64, AT + AO_KD, 128, (h >> 1) * 64, PROJ, INCP, PD_V + (h >> 1) * 64, rowb, t, false, -1e30f, o);
    else { dbg_attn_row<32>(AT + AO_QC, 256, h * 64, AT + AO_KC, 256, h * 64, PROJ, INCP, PC_V + h * 64, rowb, t, false, -1e30f, ref);
           dbg_attn_row<32>(AT + AO_QC, 256, h * 64 + 32, AT + AO_KC, 256, h * 64 + 32, PROJ, INCP, PC_V + h * 64, rowb, t, false, -1e30f, o);
           const float lam = (DBGLAM < -99.f ? ((const float*)(a.ws + WS_LAM))[l] : DBGLAM), omul = 1.f - (0.8f - 0.6f * __expf(-0.3f * (float)l)); float ss = 0.f;
#pragma unroll
           for (int d = 0; d < 64; ++d) { o[d] = ref[d] - lam * o[d]; ss += o[d] * o[d]; }
           const float rs = rsqrtf(ss * (1.f / 64.f) + EPS);
#pragma unroll
           for (int d = 0; d < 64; ++d) o[d] = o[d] * rs * arg_in(a, I_CSUBLN)[l * 64 + d] * omul; }
    const int oo = mixer == 0 ? 0 : mixer == 1 ? 256 : mixer == 2 ? 512 : 768; float err = 0.f, nrm = 0.f;
#pragma unroll
    for (int d = 0; d < 64; ++d) { const float g = bf2f(MIX[(rowb + t) * DM + oo + h * 64 + d]); err += (g - o[d]) * (g - o[d]); nrm += o[d] * o[d]; }
    if (!(err <= 1e-3f * nrm + 1e-7f)) dbg_fail(a, id + mixer);
}
#endif
#ifndef PHMASK
#define PHMASK 0xFFFF
#endif
#define PHON(b) ((PHMASK >> (b)) & 1)
#ifndef DBGMIX
#define DBGMIX 0
#endif
#define MIXON(b) (((DBGMIX >> (b)) & 1) ? 0.f : 1.f)
#ifndef DBGS_A0
#define DBGS_A0 1.f
#define DBGS_A1 1.f
#define DBGS_M0 1.f
#define DBGS_M1 1.f
#endif
#ifndef DBGNOCTX
#define DBGNOCTX 0
#endif
#ifndef DBGLAM
#define DBGLAM -100.f
#endif
#ifndef DBGFORCE
#define DBGFORCE 0
#endif
#ifndef BGHOOKS
#define BGHOOKS 1
#endif
#ifndef DUPROWSONLY
#define DUPROWSONLY 1
#endif
#ifndef EXTRABAR
#define EXTRABAR 0
#endif
#ifndef LOCTEST
#define LOCTEST 0
#endif
#ifndef DUPMASK
#define DUPMASK 0
#endif
#ifndef SPLITCTX
#define SPLITCTX 1
#endif
#ifndef DBGSKIP
#define DBGSKIP 0
#endif
constexpr int STEPS_PER_LAYER = 11, NSTEPS = 1 + DEPTH * STEPS_PER_LAYER;

__global__ void __launch_bounds__(NTHREADS, 2) fwd_kernel(const float* p0, const float* p1, const float* p2, const float* p3, const float* p4, const float* p5, const float* p6, const float* p7, const float* p8, const float* p9, const float* p10, const float* p11, const float* p12, const float* p13, const float* p14, const float* p15, const float* p16, const float* p17, const float* p18, const float* p19, const float* p20, const float* p21, const float* p22, const float* p23, float* p_out, unsigned char* p_ws, int p_lo, int p_hi) {
    extern __shared__ __attribute__((aligned(16))) unsigned char lds[];
    Args args; args.ka = (kaptr_t)__builtin_amdgcn_kernarg_segment_ptr(); args.out = p_out; args.ws = p_ws; args.lo = p_lo; args.hi = p_hi;
    const int G = gridDim.x, bx = blockIdx.x;
    const bool split = SPLITCTX && G >= 128;
    volatile LAS unsigned* MISC = (volatile LAS unsigned*)((LAS unsigned char*)lds + MISC_OFF);
    if (threadIdx.x < 64) MISC[threadIdx.x] = 0u;
    __syncthreads();
#if DBGCHK
    if (args.lo >= 100) {
        const int kind = args.lo - 100, l = args.hi; const bool last = (l == DEPTH - 1); const int id0 = l * 12;
        if (kind == 0) dbg_chk_inproj(args, l, id0 + 0);
        else if (kind == 1) dbg_chk_bup(args, l, id0 + 1);
        else if (kind == 2) dbg_chk_attn(args, l, last, id0 + 3);
        else if (kind == 3) dbg_chk_topk(args, last, id0 + 9, lds);
        else if (kind == 4) dbg_chk_moe(args, l, last, id0 + 7);
        return;
    }
#endif
    const bool coop = (args.hi - args.lo) > 1;
    XcdBarrier bar; bar.bar = (unsigned*)(args.ws + WS_CTL); bar.x = 0; bar.st = nullptr;
    if (coop) bar = xcd_barrier_post((unsigned*)(args.ws + WS_CTL), MISC + 8);
    bool duprep = false;
    for (int step = args.lo; step < args.hi; ++step) {
        Args la = args; { size_t z_ = 0; asm volatile("" : "+s"(z_)); la.ws = args.ws + z_; la.ka = args.ka + z_; }
        unsigned char* ws = la.ws; bf16_t* AT = (bf16_t*)(ws + WS_ATT);
        const int l = step == 0 ? 0 : (step - 1) / STEPS_PER_LAYER, s = step == 0 ? -1 : (step - 1) % STEPS_PER_LAYER;
        const bool last = (l == DEPTH - 1);
        if (s == 0 && l > 0) continue;
        if (PHON(0) && step == 0) p0_prologue(la, lds);
        else if (PHON(1) && s == 0) p1_norm1_l0(la);
        if (PHON(2) && (s == 1 || s == 2)) {
            if (!(DUPROWSONLY && duprep && s == 2)) {
                pg8::Gemm g; pg8::Sched S; pg8::EpiBf16 E;
                if (s == 1) { g = pg8::Gemm{(const bf16_t*)(ws + WS_H), (const bf16_t*)(ws + WS_WIN) + (size_t)l * INCP * DM, DM, DM, DM, nullptr, 0, 0}; S.init(NR / 256, INCP / 256, G, bx, 0); E = pg8::EpiBf16{(bf16_t*)(ws + WS_PROJ), INCP, 0}; }
                else if (s == 2) { g = pg8::Gemm{(const bf16_t*)(ws + WS_PROJ) + PB_CQ, (const bf16_t*)(ws + WS_WUQ) + (size_t)l * 2 * 512 * 256, INCP, 256, 256, nullptr, (size_t)512 * 256, (size_t)(PB_CKV - PB_CQ)};
                    S.init(132, 2, G, bx, 3); E = pg8::EpiBf16{AT + AO_QBR, 512, (size_t)NR * 512}; }
                pg8::gemm_phase<pg8::EpiBf16, false>((LAS unsigned char*)lds, (LAS int*)((LAS unsigned char*)lds + GIDX_OFF), g, S, E);
                if (BGHOOKS && s != 2 && (S.units() < S.max_units() || S.nwg % G == 0)) { const int rk = S.c - S.nwg % G, nrk = G - S.nwg % G;
                    if (l == 0) bg_convert(la, 0, 0, BG0_A, rk, nrk, lds); else bg_convert(la, 1, BG1_U + BG1_D, BG1_A, rk, nrk, lds); }
            }
            if (PHON(3) && s == 2) { const int nbusy = (264 > G && 264 <= 2 * G) ? 264 - G : 0;
                if (bx >= nbusy) p3_rows(la, l, bx - nbusy, G - nbusy); }
        }
        if (PHON(3) && s == 3) p3c_rows(la);
        if (PHON(4) && s == 4) {
            const float* LAMv = (const float*)(ws + WS_LAM);
            const bf16_t* PROJ = (const bf16_t*)(ws + WS_PROJ); bf16_t* MIX = (bf16_t*)(ws + WS_MIX);
            const int nu = 256 + (last ? 0 : 8);
            if (PHON(10)) { const att::Desc D{AT + AO_QB, 384, 0, AT + AO_KB, 384, 0, AT + AO_VB, 256, 0, MIX, 256, 0, nullptr, nullptr};
              unsigned redo = 0u;
              for (int u = bx, i = 0; u < nu; u += G, ++i) { const bool cx = u >= 256; const int bh = cx ? u - 256 : (LOCTEST ? (u >> 5) : (u & 7)), b = bh >> 2, h = bh & 3, qt0 = cx ? 0 : 256 * ((LOCTEST ? (u & 31) : (u >> 3)) + 1);
                  if (att::attn_unit_d<1, 6, false, true>(D, b, h, h, h, qt0, cx ? 4 : 132, 4, false, att::NEGBIG, 0.f, nullptr, MIXON(1), lds) || (DBGFORCE && (u & 1))) redo |= 1u << (i & 31); }
              if (redo) for (int u = bx, i = 0; u < nu; u += G, ++i) if ((redo >> (i & 31)) & 1u) { const bool cx = u >= 256; const int bh = cx ? u - 256 : (LOCTEST ? (u >> 5) : (u & 7)), b = bh >> 2, h = bh & 3, qt0 = cx ? 0 : 256 * ((LOCTEST ? (u & 31) : (u >> 3)) + 1);
                  att::attn_unit<1, 6, false>(D, b, h, h, h, qt0, cx ? 4 : 132, 4, false, att::NEGBIG, 0.f, nullptr, MIXON(1), lds); } }
            if (PHON(11)) { const att::Desc D{PROJ, INCP, PC_Q, AT + AO_KC, 256, 0, PROJ, INCP, PC_V, MIX, 512, 3, (const float*)(ws + WS_TAB32), nullptr};
              const float lam = (DBGLAM < -99.f ? LAMv[l] : DBGLAM), omul = (1.f - (0.8f - 0.6f * __expf(-0.3f * (float)l))) * MIXON(2);
              unsigned redo = 0u;
              for (int u = (bx + G - 8 % G) % G, i = 0; u < nu; u += G, ++i) { const bool cx = u >= 256; const int bh = cx ? u - 256 : (LOCTEST ? (u >> 5) : (u & 7)), b = bh >> 2, h = bh & 3, qt0 = cx ? 0 : 256 * ((LOCTEST ? (u & 31) : (u >> 3)) + 1);
                  if (att::attn_unit<2, 2, false, true>(D, b, h, h, h, qt0, cx ? 4 : 132, 4, false, att::NEGBIG, lam, arg_in(la, I_CSUBLN) + l * 64, omul, lds) || (DBGFORCE && (u & 1))) redo |= 1u << (i & 31); }
              if (redo) for (int u = (bx + G - 8 % G) % G, i = 0; u < nu; u += G, ++i) if ((redo >> (i & 31)) & 1u) { const bool cx = u >= 256; const int bh = cx ? u - 256 : (LOCTEST ? (u >> 5) : (u & 7)), b = bh >> 2, h = bh & 3, qt0 = cx ? 0 : 256 * ((LOCTEST ? (u & 31) : (u >> 3)) + 1);
                  att::attn_unit<2, 2, false>(D, b, h, h, h, qt0, cx ? 4 : 132, 4, false, att::NEGBIG, lam, arg_in(la, I_CSUBLN) + l * 64, omul, lds); } }
            if (PHON(12)) for (int mx = 0; mx < 2; ++mx) {
                const att::Desc D = mx == 0 ? att::Desc{PROJ, INCP, PD_Q, AT + AO_KD, 128, 0, PROJ, INCP, PD_V, MIX, 768, 2, (const float*)(ws + WS_TAB64), arg_in(la, I_DQN) + l * 64}
                                            : att::Desc{PROJ, INCP, PA_Q, AT + AO_KA, 128, 0, PROJ, INCP, PA_V, MIX, 0, 1, (const float*)(ws + WS_TAB64), nullptr};
                unsigned redo = 0u;
                for (int pass = 0; pass < 2; ++pass) { if (pass == 1 && redo == 0u) break;
                for (int u = (bx + G - (16 + 8 * mx) % G) % G, i = 0; u < nu; u += G, ++i) { if (pass == 1 && !((redo >> (i & 31)) & 1u)) continue;
                    const bool cx = u >= 256; const int bh = cx ? u - 256 : (LOCTEST ? (u >> 5) : (u & 7)), b = bh >> 2, h = bh & 3, qb = (LOCTEST ? (u & 31) : (u >> 3)) + 1, qt0 = cx ? 0 : 256 * qb;
                    int ntile = cx ? 4 : 132, wstart = 4; bool win = false; float sink2 = att::NEGBIG;
                    if (mx == 1) { sink2 = arg_in(la, I_ASINK)[l * 4 + h] * LOG2E;
                        if (!cx) { const int ws_ = (4 * qb - 2) < 4 ? 4 : (4 * qb - 2), we_ = (4 * qb + 5) > 131 ? 131 : (4 * qb + 5); wstart = ws_; ntile = 4 + we_ - ws_ + 1; win = true; } }
                    if (pass == 0) { if (att::attn_unit_d<1, 4, true, true>(D, b, h, h >> 1, h >> 1, qt0, ntile, wstart, win, sink2, 0.f, nullptr, mx == 0 ? MIXON(3) : MIXON(0), lds) || (DBGFORCE && (u & 1))) redo |= 1u << (i & 31); }
                    else att::attn_unit<1, 4, true>(D, b, h, h >> 1, h >> 1, qt0, ntile, wstart, win, sink2, 0.f, nullptr, mx == 0 ? MIXON(3) : MIXON(0), lds); } } }
        }
        const bool ctxgemm = (s == 6 && !last && split && bx < 8);
        if (PHON(5) && (s == 5 || ctxgemm)) {
            pg8::Gemm g{(const bf16_t*)(ws + WS_MIX), (const bf16_t*)(ws + WS_WOUT) + (size_t)l * DM * DM, DM, DM, DM, nullptr, 0, 0};
            pg8::Sched S; if (s == 5) S.init((last || split) ? 64 : 66, 4, G, bx, (last || split) ? 1 : 0); else S.init(2, 4, 8, bx, 4);
            pg8::EpiResid E{(bf16_t*)(ws + WS_X), (const float*)(ws + WS_MOD) + (size_t)l * 3 * 6144 + 2048, 6144, duprep ? 0.f : (l == 0 ? DBGS_A0 : DBGS_A1)};
            pg8::gemm_phase<pg8::EpiResid, false>((LAS unsigned char*)lds, (LAS int*)((LAS unsigned char*)lds + GIDX_OFF), g, S, E);
            if (BGHOOKS && s == 5 && l == 0 && BG0_B > 0 && (S.units() < S.max_units() || S.nwg % G == 0)) bg_convert(la, 0, BG0_A, BG0_B, S.c - S.nwg % G, G - S.nwg % G, lds);
        }
        { int p6rows = -1, p6rank = 0, p6n = 1;
          if (s == 6 && !ctxgemm) { if (!last && split) { p6rows = 1; p6rank = bx - 8; p6n = G - 8; } else { p6rows = 0; p6rank = bx; p6n = G; } }
          if (s == 7 && !last && split && bx >= 64 && bx < 128) { p6rows = 2; p6rank = bx - 64; p6n = 64; }
          if (PHON(6) && p6rows >= 0) p6_norm2_router(la, l, last, p6rows, p6rank, p6n, lds); }
        if (PHON(7) && s == 7) { const int np = last ? 32 : 64;
            unsigned* ctxcnt = (unsigned*)(ws + WS_BGCNT);
            if (!last && split && bx >= 64 && bx < 128) {
                if (threadIdx.x == 0 && !duprep) { __builtin_amdgcn_fence(__ATOMIC_RELEASE, "agent"); asm volatile("s_waitcnt vmcnt(0)" ::: "memory"); (void)xb_add(ctxcnt, 1u); } }
            if (!last && split && bx >= 32 && bx < 64) {
                if (threadIdx.x == 0) { unsigned sp = 0u; while (xb_ld(ctxcnt) < 64u && ++sp < XB_SPIN_CAP) __builtin_amdgcn_s_sleep(1);
                    __builtin_amdgcn_fence(__ATOMIC_ACQUIRE, "agent"); asm volatile("s_waitcnt vmcnt(0)" ::: "memory"); }
                __syncthreads(); }
            for (int q = bx; q < np; q += G) p7_topk(la, q, lds);
            { const int first = BGHOOKS ? (l == 0 ? BG0_A + BG0_B : BG1_U + BG1_D + BG1_A) : 0;
              if (G > np) { if (bx >= np) bg_convert(la, l, first, CI_MOE - first, bx - np, G - np, lds); } else bg_convert(la, l, first, CI_MOE - first, bx, G, lds); } }
        if (PHON(8) && s == 8) {
            pg8::Gemm g{(const bf16_t*)(ws + WS_H), (const bf16_t*)(ws + WS_WGU + (size_t)l * WS_WL), DM / 2, DM / 2, DM / 2, (const int*)(ws + WS_IDX), (size_t)2048 * DM / 2, 0};
            pg8::Sched S; S.init(last ? 128 : 144, 8, G, bx, 2);
            pg8::EpiSwiGLU8 E{ws + WS_PROJ, DM};
            pg8::gemm_phase<pg8::EpiSwiGLU8, true, true>((LAS unsigned char*)lds, (LAS int*)((LAS unsigned char*)lds + GIDX_OFF), g, S, E);
            if (BGHOOKS && !last && (S.units() < S.max_units() || S.nwg % G == 0)) bg_convert(la, l + 1, 0, BG1_U, S.c - S.nwg % G, G - S.nwg % G, lds);
        }
        if (PHON(2) && s == 9) {
            pg8::Gemm g{(const bf16_t*)(ws + WS_PROJ), (const bf16_t*)(ws + WS_WDN + (size_t)l * WS_WL), DM / 2, DM / 2, DM / 2, nullptr, (size_t)DM * DM / 2, 0};
            pg8::Sched S; S.init(last ? 128 : 144, 4, G, bx, 2);
            pg8::EpiFp8 E{ws + WS_ATT, DM};
            pg8::gemm_phase<pg8::EpiFp8, false, true>((LAS unsigned char*)lds, (LAS int*)((LAS unsigned char*)lds + GIDX_OFF), g, S, E);
            if (BGHOOKS && !last && (S.units() < S.max_units() || S.nwg % G == 0)) bg_convert(la, l + 1, BG1_U, BG1_D, S.c - S.nwg % G, G - S.nwg % G, lds);
        }
        if (PHON(9) && s == 10) {
            float dbgmul = 1.f;
#if DBGCHK
            if (last) { const int* fl = (const int*)(ws + WS_DBG); for (int q = 31; q >= 0; --q) if (fl[q] != 0) dbgmul = 2.f + (float)q; }
#endif
            p10_combine(la, l, last, duprep ? 0.f : (l == 0 ? DBGS_M0 : DBGS_M1), dbgmul);
        }
        if (step + 1 < args.hi) xcd_barrier(bar);
        if (EXTRABAR && step + 1 < args.hi && step == 1) for (int q = 0; q < EXTRABAR; ++q) xcd_barrier(bar);
        if (DUPMASK != 0) { const int bit = step == 0 ? 11 : s; if (((DUPMASK >> bit) & 1) && !duprep) { duprep = true; --step; } else duprep = false; }
    }
}

extern "C" void kernel_launch(void* const* d_in, const int* in_sizes, int n_in, void* d_out, int out_size, void* d_ws, size_t ws_size, hipStream_t stream) {
    static int grid = 0;
    if (grid == 0) {
        if (n_in != 24 || out_size != NBATCH * SEQ * DM || ws_size < WS_END) { fprintf(stderr, "kernel_launch: unexpected shapes (n_in %d, out %d, ws %zu < %zu); nothing launched\n", n_in, out_size, ws_size, (size_t)WS_END); grid = -1; return; }
        int dev = 0, cus = 0, per_cu = 0;
        if (hipGetDevice(&dev) != hipSuccess || hipDeviceGetAttribute(&cus, hipDeviceAttributeMultiprocessorCount, dev) != hipSuccess) { grid = -1; return; }
        if (hipFuncSetAttribute((const void*)fwd_kernel, hipFuncAttributeMaxDynamicSharedMemorySize, LDS_BYTES) != hipSuccess) { fprintf(stderr, "kernel_launch: hipFuncSetAttribute failed\n"); grid = -1; return; }
        if (hipOccupancyMaxActiveBlocksPerMultiprocessor(&per_cu, (const void*)fwd_kernel, NTHREADS, LDS_BYTES) != hipSuccess || per_cu < 1) { fprintf(stderr, "kernel_launch: occupancy query says %d blocks per CU\n", per_cu); (void)hipGetLastError(); per_cu = 1; }
        grid = cus;
    }
    if (grid < 0) return;
    (void)hipMemsetAsync((char*)d_ws + WS_CTL, 0, CTL_ZERO_BYTES, stream);
    const float* pin[24]; for (int i = 0; i < 24; ++i) pin[i] = (const float*)d_in[i];
    float* pout = (float*)d_out; unsigned char* pws = (unsigned char*)d_ws; int lo = 0, hi = NSTEPS;
    void* kargs[28]; for (int i = 0; i < 24; ++i) kargs[i] = (void*)&pin[i];
    kargs[24] = (void*)&pout; kargs[25] = (void*)&pws; kargs[26] = (void*)&lo; kargs[27] = (void*)&hi;
#if MK_LAUNCHES == 1
    hipError_t e = hipLaunchKernel((const void*)fwd_kernel, dim3(grid), dim3(NTHREADS), kargs, LDS_BYTES, stream);
    if (e != hipSuccess) fprintf(stderr, "kernel_launch: launch failed: %s (grid %d)\n", hipGetErrorString(e), grid);
#else
    for (int st = 0; st < NSTEPS; ++st) {
        if (st > 1 && (st - 1) % STEPS_PER_LAYER == 0) continue;
        lo = st; hi = st + 1;
        (void)hipLaunchKernel((const void*)fwd_kernel, dim3(grid), dim3(NTHREADS), kargs, LDS_BYTES, stream);
#if DBGCHK
        if (st >= 1) { const int l_ = (st - 1) / STEPS_PER_LAYER, s_ = (st - 1) % STEPS_PER_LAYER; const int kind = s_ == 1 ? 0 : s_ == 2 ? 1 : s_ == 4 ? 2 : s_ == 7 ? 3 : s_ == 9 ? 4 : -1;
            if (kind >= 0) { lo = 100 + kind; hi = l_; (void)hipLaunchKernel((const void*)fwd_kernel, dim3(grid), dim3(NTHREADS), kargs, LDS_BYTES, stream); } }
#endif
    }
#endif
}
```
